# Optimizing an MI355X kernel written in HIP

```python
import jax, jax.numpy as jnp
from jax import lax
import numpy as np

D_MODEL = 1024
BATCH = 4
SEQ = 4096
DEPTH = 4

CHUNK = 64
N_MIXERS = 2
EPS = 1e-6
GM_BLOCK = 128
GM_HEADS = 8
GM_WIDTH = 2 * D_MODEL
GM_HEAD_DIM = GM_WIDTH // GM_HEADS
HG_EXPAND = 128
HG_HEADS = D_MODEL // HG_EXPAND
HG_KEY = HG_EXPAND
HG_VAL = D_MODEL // HG_HEADS
FFN_HIDDEN = 2816
CONV_WIDTH = 3
N_A = (DEPTH + 1) // 2
N_B = DEPTH // 2

kernel_name = "hybrid_gmlp_hgrn2_convffn_adaln"


def rms_norm(x, g):
    xf = x.astype(jnp.float32)
    y = xf * lax.rsqrt(jnp.mean(xf * xf, axis=-1, keepdims=True) + EPS)
    return (y * g.astype(jnp.float32)).astype(x.dtype)


def chunk_causal_mask(n):
    idx = jnp.arange(n) // CHUNK
    return idx[:, None] >= idx[None, :]


def spatial_gating_mixer(h, w_in, ln_g, ln_b, w_s, b_s, w_out):
    bsz, t, _ = h.shape
    z = jax.nn.gelu(h @ w_in, approximate=False)
    u, v = jnp.split(z, 2, axis=-1)
    vf = v.astype(jnp.float32)
    mu = jnp.mean(vf, axis=-1, keepdims=True)
    var = jnp.mean(jnp.square(vf - mu), axis=-1, keepdims=True)
    v = ((vf - mu) * lax.rsqrt(var + EPS) * ln_g + ln_b).astype(h.dtype)
    v = v.reshape(bsz, t // GM_BLOCK, GM_BLOCK, GM_HEADS, GM_HEAD_DIM)
    ws = jnp.where(chunk_causal_mask(GM_BLOCK)[None], w_s, 0)
    s = jnp.einsum('hnm,bcmhd->bcnhd', ws, v) + b_s.T[None, None, :, :, None]
    gated = u * s.reshape(bsz, t, GM_WIDTH)
    return gated @ w_out


def hgrn2_chunked_scan(q, k, v, logf):
    bsz, t, nh, dk = q.shape
    dv = v.shape[-1]
    nc = t // CHUNK

    def to_chunks(a):
        return a.reshape(bsz, nc, CHUNK, nh, a.shape[-1]).transpose(1, 0, 3, 2, 4)

    causal = jnp.tril(jnp.ones((CHUNK, CHUNK), dtype=bool))[:, :, None]

    def step(state, inp):
        qc, kc, vc, gc = inp
        cum = jnp.cumsum(gc, axis=-2)
        rel = cum[..., :, None, :] - cum[..., None, :, :]
        decay = jnp.exp(jnp.where(causal, rel, -jnp.inf))
        scores = jnp.einsum('bhik,bhjk,bhijk->bhij', qc, kc, decay)
        out = jnp.einsum('bhij,bhjv->bhiv', scores, vc) + \
            jnp.einsum('bhik,bhkv->bhiv', qc * jnp.exp(cum), state)
        last = cum[..., -1:, :]
        state = jnp.exp(last)[..., 0, :, None] * state + \
            jnp.einsum('bhjk,bhjv->bhkv', kc * jnp.exp(last - cum), vc)
        return state, out

    s0 = jnp.zeros((bsz, nh, dk, dv), jnp.float32)
    _, out = lax.scan(step, s0, (to_chunks(q), to_chunks(k), to_chunks(v), to_chunks(logf)))
    return out.transpose(1, 0, 3, 2, 4).reshape(bsz, t, nh, dv)


def hgrn2_mixer(h, w_in, lb, gn_g, w_out):
    bsz, t, _ = h.shape
    q, fz, i, g = jnp.split(h @ w_in, 4, axis=-1)
    f = lb + (1.0 - lb) * jax.nn.sigmoid(fz.astype(jnp.float32))
    logf = jnp.log(f)
    k = 1.0 - f
    q = jax.nn.silu(q).astype(jnp.float32)

    def heads(a):
        return a.reshape(bsz, t, HG_HEADS, -1)

    o = hgrn2_chunked_scan(heads(q), heads(k), heads(i.astype(jnp.float32)), heads(logf))
    o = o * lax.rsqrt(jnp.mean(o * o, axis=-1, keepdims=True) + EPS)
    o = (o.reshape(bsz, t, HG_HEADS * HG_VAL) * gn_g.astype(jnp.float32)).astype(h.dtype)
    return (o * jax.nn.silu(g)) @ w_out


def conv_ffn(h, w_up, conv_w, conv_b, w_down):
    t = h.shape[1]
    a = h @ w_up
    ap = jnp.pad(a, ((0, 0), (CONV_WIDTH - 1, 0), (0, 0)))
    y = conv_b
    for j in range(CONV_WIDTH):
        y = y + conv_w[j] * ap[:, j:j + t]
    gate, val = jnp.split(y, 2, axis=-1)
    return (jax.nn.gelu(gate, approximate=False) * val) @ w_down


def setup_inputs(seed: int = 0) -> dict:
    key = jax.random.key(seed)
    ks = jax.random.split(key, 20)
    nrm = jax.random.normal
    f32 = jnp.float32
    D, F2 = D_MODEL, 2 * FFN_HIDDEN
    return {
        "x": nrm(ks[0], (BATCH, SEQ, D), f32),
        "c": nrm(ks[1], (BATCH, D), f32),
        "gm_w_in": nrm(ks[2], (N_A, D, 2 * GM_WIDTH), f32) * D ** -0.5,
        "gm_ln_g": 1.0 + 0.02 * nrm(ks[3], (N_A, GM_WIDTH), f32),
        "gm_ln_b": 0.02 * nrm(ks[4], (N_A, GM_WIDTH), f32),
        "gm_w_s": nrm(ks[5], (N_A, GM_HEADS, GM_BLOCK, GM_BLOCK), f32) * GM_BLOCK ** -0.5,
        "gm_b_s": 1.0 + 0.1 * nrm(ks[6], (N_A, GM_HEADS, GM_BLOCK), f32),
        "gm_w_out": nrm(ks[7], (N_A, GM_WIDTH, D), f32) * GM_WIDTH ** -0.5,
        "hg_w_in": nrm(ks[8], (N_B, D, 4 * D), f32) * D ** -0.5,
        "hg_lb": 0.5 * nrm(ks[9], (N_B, D), f32),
        "hg_gn_g": 1.0 + 0.02 * nrm(ks[10], (N_B, D), f32),
        "hg_w_out": nrm(ks[11], (N_B, D, D), f32) * D ** -0.5,
        "ffn_w_up": nrm(ks[12], (DEPTH, D, F2), f32) * D ** -0.5,
        "ffn_conv_w": nrm(ks[13], (DEPTH, CONV_WIDTH, F2), f32) * CONV_WIDTH ** -0.5,
        "ffn_conv_b": 0.02 * nrm(ks[14], (DEPTH, F2), f32),
        "ffn_w_down": nrm(ks[15], (DEPTH, FFN_HIDDEN, D), f32) * FFN_HIDDEN ** -0.5,
        "norm_g": 1.0 + 0.02 * nrm(ks[16], (DEPTH, 2, D), f32),
        "ada_w": nrm(ks[17], (DEPTH, D, 6 * D), f32) * D ** -0.5,
        "ada_b": 0.02 * nrm(ks[18], (DEPTH, 6 * D), f32),
        "final_g": 1.0 + 0.02 * nrm(ks[19], (D,), f32),
    }


def reference(x, c, gm_w_in, gm_ln_g, gm_ln_b, gm_w_s, gm_b_s, gm_w_out,
              hg_w_in, hg_lb, hg_gn_g, hg_w_out,
              ffn_w_up, ffn_conv_w, ffn_conv_b, ffn_w_down,
              norm_g, ada_w, ada_b, final_g):
    lb_p = jax.nn.softmax(hg_lb.astype(jnp.float32), axis=0)
    lb_all = jnp.cumsum(lb_p, axis=0) - lb_p[0]
    cond = jax.nn.silu(c)
    for i in range(DEPTH):
        mod = (cond @ ada_w[i] + ada_b[i])[:, None, :]
        sh1, sc1, g1, sh2, sc2, g2 = jnp.split(mod, 6, axis=-1)
        h = rms_norm(x, norm_g[i, 0]) * (1.0 + sc1) + sh1
        j = i // N_MIXERS
        if i % N_MIXERS == 0:
            y = spatial_gating_mixer(h, gm_w_in[j], gm_ln_g[j], gm_ln_b[j],
                                     gm_w_s[j], gm_b_s[j], gm_w_out[j])
        else:
            y = hgrn2_mixer(h, hg_w_in[j], lb_all[j], hg_gn_g[j], hg_w_out[j])
        x = x + g1 * y
        h = rms_norm(x, norm_g[i, 1]) * (1.0 + sc2) + sh2
        x = x + g2 * conv_ffn(h, ffn_w_up[i], ffn_conv_w[i], ffn_conv_b[i], ffn_w_down[i])
    return rms_norm(x, final_g)
```

```cpp
#include <hip/hip_runtime.h>
#include <math.h>

namespace nv {
constexpr int D = 1024, NB = 4, T = 4096, DEPTH = 4, F = 2816, F2 = 5632, GW = 2048;
constexpr float EPS = 1e-6f;

__device__ __forceinline__ float sigmoidf_(float v) { return 1.f / (1.f + expf(-v)); }
__device__ __forceinline__ float siluf_(float v) { return v / (1.f + expf(-v)); }
__device__ __forceinline__ float geluf_(float v) { return 0.5f * v * (1.f + erff(v * 0.70710678118654752f)); }

__global__ __launch_bounds__(256) void k_ada(const float* c, const float* ada_w, const float* ada_b, float* mod) {
    __shared__ float cond[4][1024];
    for (int i = threadIdx.x; i < 4096; i += 256) { float v = c[i]; cond[i >> 10][i & 1023] = siluf_(v); }
    __syncthreads();
    const int layer = blockIdx.y, n = blockIdx.x * 256 + threadIdx.x;
    const float* W = ada_w + (size_t)layer * 1024 * 6144;
    float a0 = 0, a1 = 0, a2 = 0, a3 = 0;
    for (int k = 0; k < 1024; ++k) { float w = W[(size_t)k * 6144 + n]; a0 += cond[0][k] * w; a1 += cond[1][k] * w; a2 += cond[2][k] * w; a3 += cond[3][k] * w; }
    const float bb = ada_b[layer * 6144 + n];
    mod[(size_t)(layer * 4 + 0) * 6144 + n] = a0 + bb; mod[(size_t)(layer * 4 + 1) * 6144 + n] = a1 + bb;
    mod[(size_t)(layer * 4 + 2) * 6144 + n] = a2 + bb; mod[(size_t)(layer * 4 + 3) * 6144 + n] = a3 + bb;
}
__global__ void k_lb(const float* hg_lb, float* lb_all) {
    const int d = blockIdx.x * 256 + threadIdx.x; if (d >= 1024) return;
    const float l0 = hg_lb[d], l1 = hg_lb[1024 + d], m = fmaxf(l0, l1), e0 = expf(l0 - m), e1 = expf(l1 - m);
    lb_all[d] = 0.f; lb_all[1024 + d] = e1 / (e0 + e1);
}
__device__ __forceinline__ float block_sum_256(float v, float* red) {
    for (int o = 32; o >= 1; o >>= 1) v += __shfl_xor(v, o);
    __syncthreads();
    if ((threadIdx.x & 63) == 0) red[threadIdx.x >> 6] = v;
    __syncthreads();
    return red[0] + red[1] + red[2] + red[3];
}
__global__ __launch_bounds__(256) void k_norm(const float* x, const float* g, const float* sc, const float* sh, float* h) {
    __shared__ float red[4];
    const size_t row = blockIdx.x; const int c = threadIdx.x * 4;
    const float4 v = *(const float4*)(x + row * 1024 + c);
    const float ss = block_sum_256(v.x * v.x + v.y * v.y + v.z * v.z + v.w * v.w, red);
    const float rstd = rsqrtf(ss * (1.f / 1024.f) + EPS);
    const float4 gg = *(const float4*)(g + c);
    float4 o; o.x = v.x * rstd * gg.x; o.y = v.y * rstd * gg.y; o.z = v.z * rstd * gg.z; o.w = v.w * rstd * gg.w;
    if (sc) { const float4 s = *(const float4*)(sc + c), b = *(const float4*)(sh + c);
        o.x = o.x * (1.f + s.x) + b.x; o.y = o.y * (1.f + s.y) + b.y; o.z = o.z * (1.f + s.z) + b.z; o.w = o.w * (1.f + s.w) + b.w; }
    *(float4*)(h + row * 1024 + c) = o;
}
template <int MODE> __global__ __launch_bounds__(256) void k_gemm(const float* A, int lda, const float* W, int N, int K, float* C, int ldc, const float* gate) {
    __shared__ float As[8][128 + 4], Bs[8][128 + 4];
    const int tid = threadIdx.x, ty = tid >> 4, tx = tid & 15, m0 = blockIdx.y * 128, n0 = blockIdx.x * 128;
    float acc[8][8];
#pragma unroll
    for (int i = 0; i < 8; ++i)
#pragma unroll
        for (int j = 0; j < 8; ++j) acc[i][j] = 0.f;
    const int ar = tid >> 1, ak = (tid & 1) * 4, bk = tid >> 5, bn = (tid & 31) * 4;
    for (int k0 = 0; k0 < K; k0 += 8) {
        const float4 av = *(const float4*)(A + (size_t)(m0 + ar) * lda + k0 + ak);
        const float4 bv = *(const float4*)(W + (size_t)(k0 + bk) * N + n0 + bn);
        __syncthreads();
        As[ak + 0][ar] = av.x; As[ak + 1][ar] = av.y; As[ak + 2][ar] = av.z; As[ak + 3][ar] = av.w;
        *(float4*)&Bs[bk][bn] = bv;
        __syncthreads();
#pragma unroll
        for (int k = 0; k < 8; ++k) {
            float a[8], b[8];
            *(float4*)&a[0] = *(const float4*)&As[k][ty * 8]; *(float4*)&a[4] = *(const float4*)&As[k][ty * 8 + 4];
            *(float4*)&b[0] = *(const float4*)&Bs[k][tx * 8]; *(float4*)&b[4] = *(const float4*)&Bs[k][tx * 8 + 4];
#pragma unroll
            for (int i = 0; i < 8; ++i)
#pragma unroll
                for (int j = 0; j < 8; ++j) acc[i][j] += a[i] * b[j];
        }
    }
#pragma unroll
    for (int i = 0; i < 8; ++i) {
        float* cp = C + (size_t)(m0 + ty * 8 + i) * ldc + n0 + tx * 8;
#pragma unroll
        for (int j = 0; j < 8; ++j) {
            float v = acc[i][j];
            if (MODE == 1) v = geluf_(v);
            if (MODE == 2) v = cp[j] + gate[n0 + tx * 8 + j] * v;
            cp[j] = v;
        }
    }
}
__global__ __launch_bounds__(256) void k_gm_ln(float* z, const float* ln_g, const float* ln_b) {
    __shared__ float red[4];
    float* v = z + (size_t)blockIdx.x * 4096 + 2048; const int c = threadIdx.x * 8;
    float x[8]; float s = 0;
#pragma unroll
    for (int j = 0; j < 8; ++j) { x[j] = v[c + j]; s += x[j]; }
    const float mu = block_sum_256(s, red) * (1.f / 2048.f);
    float q = 0;
#pragma unroll
    for (int j = 0; j < 8; ++j) { x[j] -= mu; q += x[j] * x[j]; }
    const float var = block_sum_256(q, red) * (1.f / 2048.f), rstd = rsqrtf(var + EPS);
#pragma unroll
    for (int j = 0; j < 8; ++j) v[c + j] = x[j] * rstd * ln_g[c + j] + ln_b[c + j];
}
__global__ __launch_bounds__(256) void k_gm_spatial(float* z, const float* w_s, const float* b_s) {
    const int t = blockIdx.y, h = blockIdx.x, c = h * 256 + threadIdx.x, n = t & 127, blk = t >> 7, mlim = (n < 64) ? 64 : 128;
    const float* w = w_s + ((size_t)h * 128 + n) * 128; const float* vn = z + (size_t)(blk * 128) * 4096 + 2048 + c;
    float s = b_s[h * 128 + n];
    for (int m = 0; m < mlim; ++m) s += w[m] * vn[(size_t)m * 4096];
    z[(size_t)t * 4096 + c] *= s;
}
__global__ __launch_bounds__(128) void k_hg_scan(const float* zz, const float* lb, float* o) {
    const int h = blockIdx.x, v = threadIdx.x;
    __shared__ float sq[16][128], sf[16][128];
    float S[128];
#pragma unroll
    for (int k = 0; k < 128; ++k) S[k] = 0.f;
    const float l = lb[h * 128 + v];
    for (int t0 = 0; t0 < T; t0 += 16) {
        __syncthreads();
        for (int s = 0; s < 16; ++s) { const float* r = zz + (size_t)(t0 + s) * 4096 + h * 128 + v; sq[s][v] = siluf_(r[0]); sf[s][v] = l + (1.f - l) * sigmoidf_(r[1024]); }
        __syncthreads();
#pragma unroll 1
        for (int s = 0; s < 16; ++s) {
            const float iv = zz[(size_t)(t0 + s) * 4096 + 2048 + h * 128 + v]; float acc = 0.f;
#pragma unroll
            for (int k = 0; k < 128; ++k) { const float f = sf[s][k]; S[k] = f * S[k] + (1.f - f) * iv; acc += sq[s][k] * S[k]; }
            o[(size_t)(t0 + s) * 1024 + h * 128 + v] = acc;
        }
    }
}
__global__ __launch_bounds__(128) void k_hg_post(float* o, const float* zz, const float* gn_g) {
    __shared__ float red[2];
    const int h = blockIdx.x, v = threadIdx.x; const size_t t = blockIdx.y; const int c = h * 128 + v;
    const float x = o[t * 1024 + c]; float s = x * x;
    for (int of = 32; of >= 1; of >>= 1) s += __shfl_xor(s, of);
    if ((v & 63) == 0) red[v >> 6] = s;
    __syncthreads();
    const float rstd = rsqrtf((red[0] + red[1]) * (1.f / 128.f) + EPS);
    o[t * 1024 + c] = x * rstd * gn_g[c] * siluf_(zz[t * 4096 + 3072 + c]);
}
__global__ __launch_bounds__(256) void k_conv(const float* a, const float* cw, const float* cb, float* g) {
    const int t = blockIdx.y, c = blockIdx.x * 256 + threadIdx.x;
    float yg = cb[c], yv = cb[c + F];
#pragma unroll
    for (int j = 0; j < 3; ++j) { const int tt = t - 2 + j; if (tt >= 0) { yg += cw[j * F2 + c] * a[(size_t)tt * F2 + c]; yv += cw[j * F2 + c + F] * a[(size_t)tt * F2 + c + F]; } }
    g[(size_t)t * F + c] = geluf_(yg) * yv;
}

struct In { const float *x, *c, *gm_w_in, *gm_ln_g, *gm_ln_b, *gm_w_s, *gm_b_s, *gm_w_out, *hg_w_in, *hg_lb, *hg_gn_g, *hg_w_out, *ffn_w_up, *ffn_conv_w, *ffn_conv_b, *ffn_w_down, *norm_g, *ada_w, *ada_b, *final_g; };

static void run(const In& in, float* X, float* out, float* scratch, int b0, int b1, int nlayers, bool final, hipStream_t st) {
    float* mod = scratch;
    float* lb_all = mod + 4 * 4 * 6144;
    float* H = lb_all + 4096;
    float* Z = H + (size_t)T * 1024;
    float* G = Z + (size_t)T * F2;
    hipLaunchKernelGGL(k_ada, dim3(6144 / 256, DEPTH), dim3(256), 0, st, in.c, in.ada_w, in.ada_b, mod);
    hipLaunchKernelGGL(k_lb, dim3(4), dim3(256), 0, st, in.hg_lb, lb_all);
    for (int b = b0; b < b1; ++b) {
        float* xb = X + (size_t)b * T * 1024;
        for (int i = 0; i < nlayers; ++i) {
            const float* m = mod + (size_t)(i * 4 + b) * 6144; const int j = i / 2;
            hipLaunchKernelGGL(k_norm, dim3(T), dim3(256), 0, st, xb, in.norm_g + (size_t)(i * 2 + 0) * 1024, m + 1024, m, H);
            if (i % 2 == 0) {
                hipLaunchKernelGGL(k_gemm<1>, dim3(4096 / 128, T / 128), dim3(256), 0, st, H, 1024, in.gm_w_in + (size_t)j * 1024 * 4096, 4096, 1024, Z, 4096, nullptr);
                hipLaunchKernelGGL(k_gm_ln, dim3(T), dim3(256), 0, st, Z, in.gm_ln_g + j * 2048, in.gm_ln_b + j * 2048);
                hipLaunchKernelGGL(k_gm_spatial, dim3(8, T), dim3(256), 0, st, Z, in.gm_w_s + (size_t)j * 8 * 128 * 128, in.gm_b_s + j * 8 * 128);
                hipLaunchKernelGGL(k_gemm<2>, dim3(1024 / 128, T / 128), dim3(256), 0, st, Z, 4096, in.gm_w_out + (size_t)j * 2048 * 1024, 1024, 2048, xb, 1024, m + 2048);
            } else {
                hipLaunchKernelGGL(k_gemm<0>, dim3(4096 / 128, T / 128), dim3(256), 0, st, H, 1024, in.hg_w_in + (size_t)j * 1024 * 4096, 4096, 1024, Z, 4096, nullptr);
                hipLaunchKernelGGL(k_hg_scan, dim3(8), dim3(128), 0, st, Z, lb_all + j * 1024, G);
                hipLaunchKernelGGL(k_hg_post, dim3(8, T), dim3(128), 0, st, G, Z, in.hg_gn_g + j * 1024);
                hipLaunchKernelGGL(k_gemm<2>, dim3(1024 / 128, T / 128), dim3(256), 0, st, G, 1024, in.hg_w_out + (size_t)j * 1024 * 1024, 1024, 1024, xb, 1024, m + 2048);
            }
            hipLaunchKernelGGL(k_norm, dim3(T), dim3(256), 0, st, xb, in.norm_g + (size_t)(i * 2 + 1) * 1024, m + 4096, m + 3072, H);
            hipLaunchKernelGGL(k_gemm<0>, dim3(F2 / 128, T / 128), dim3(256), 0, st, H, 1024, in.ffn_w_up + (size_t)i * 1024 * F2, F2, 1024, Z, F2, nullptr);
            hipLaunchKernelGGL(k_conv, dim3(F / 256, T), dim3(256), 0, st, Z, in.ffn_conv_w + (size_t)i * 3 * F2, in.ffn_conv_b + (size_t)i * F2, G);
            hipLaunchKernelGGL(k_gemm<2>, dim3(1024 / 128, T / 128), dim3(256), 0, st, G, F, in.ffn_w_down + (size_t)i * F * 1024, 1024, F, xb, 1024, m + 5120);
        }
        if (final) hipLaunchKernelGGL(k_norm, dim3(T), dim3(256), 0, st, xb, in.final_g, nullptr, nullptr, out + (size_t)b * T * 1024);
    }
}
}

#ifndef NV_NO_MAIN
extern "C" void kernel_launch(void* const* d_in, const int* in_sizes, int n_in, void* d_out, int out_size, void* d_ws, size_t ws_size, hipStream_t stream) {
    nv::In in{};
    const float** p = (const float**)&in;
    for (int i = 0; i < 20; ++i) p[i] = (const float*)d_in[i];
    float* X = (float*)d_out;
    hipMemcpyAsync(X, in.x, (size_t)nv::NB * nv::T * 1024 * 4, hipMemcpyDeviceToDevice, stream);
    nv::run(in, X, X, (float*)d_ws, 0, nv::NB, nv::DEPTH, true, stream);
}
#endif
```

```cpp
#include <hip/hip_runtime.h>
#include <hip/hip_cooperative_groups.h>
#include <cstdio>
#define MK_N_LAUNCHES 0
#define MK_SP2_UP true
namespace pg8 {
#define PG8_LAS __attribute__((address_space(3)))
typedef unsigned short bf16_t;
typedef short bf16x8 __attribute__((ext_vector_type(8)));
typedef float f32x4 __attribute__((ext_vector_type(4)));
typedef unsigned u32x4 __attribute__((ext_vector_type(4)));
constexpr int BM = 256, BK = 64, HALF = 128, HTB = HALF * BK * 2  , STAGE_BYTES = 8 * HTB, NXCD = 8, WGM = 8;

__host__ __device__ __forceinline__ int lds_byte(int r, int c) { const int st = (r >> 4) * 2 + (c >> 5), rr = r & 15, cc = c & 31, ob = rr * 64 + cc * 2; return st * 1024 + (ob ^ (((ob >> 9) & 1) << 5)); }
__host__ __device__ __forceinline__ void stage_rc(int b, int& R, int& C) { const int st = b / 1024, sb = b % 1024, swz = sb ^ (((sb >> 9) & 1) << 5); R = (st >> 1) * 16 + swz / 64; C = (st & 1) * 32 + (swz % 64) / 2; }
__host__ __device__ __forceinline__ int perm32(int rho) { const int n = rho >> 4, i = rho & 15; return 8 * (i >> 2) + 4 * n + (i & 3); }

struct Unit { int pm, pn; };
struct Gemm { const bf16_t* A; const bf16_t* Bt; int M, N, K; };

struct StaticOrder {
    int nM, nN, nwg, G, c;
    __host__ __device__ __forceinline__ void init(int M, int N, int G_, int c_) { nM = M / BM; nN = N / BM; nwg = nM * nN; G = G_; c = c_; }
    __host__ __device__ __forceinline__ bool next(int i, Unit& u) const {
        const long L = (long)i * G + c; if (L >= nwg) return false;
        int wgid = (int)L; { const int q = nwg / NXCD, r = nwg % NXCD, xcd = wgid % NXCD, off = wgid / NXCD; wgid = (xcd < r ? xcd * (q + 1) : r * (q + 1) + (xcd - r) * q) + off; }
        const int nig = WGM * nN, gid = wgid / nig, fm = gid * WGM, gsz = (nM - fm) < WGM ? (nM - fm) : WGM;
        u.pm = fm + ((wgid % nig) % gsz); u.pn = (wgid % nig) / gsz; return true;
    }
    __device__ __forceinline__ void a_ready(const Unit&) const {}
    __device__ __forceinline__ void done(const Unit&) const {}
};

__device__ __forceinline__ unsigned cvt_pk_bf16(float lo, float hi) { unsigned r; asm volatile("v_cvt_pk_bf16_f32 %0, %1, %2" : "=v"(r) : "v"(lo), "v"(hi)); return r; }
typedef float f32x2 __attribute__((ext_vector_type(2)));
__device__ __forceinline__ f32x2 gelu_pk(f32x2 v) {
    const f32x2 av = __builtin_elementwise_abs(v), d = av * 0.2316418882f + 1.0f;
    f32x2 t; t.x = __builtin_amdgcn_rcpf(d.x); t.y = __builtin_amdgcn_rcpf(d.y);
    f32x2 q = t * 0.5307027145f + (-0.7265760135f); q = q * t + 0.7107068705f; q = q * t + (-0.142248368f); q = q * t + 0.127414796f; q = q * t;
    const f32x2 s = (v * v) * (-0.72134752044f);
    f32x2 e; e.x = __builtin_amdgcn_exp2f(s.x); e.y = __builtin_amdgcn_exp2f(s.y);
    const f32x2 m = v * (q * e), r = v - m;
    f32x2 o; o.x = v.x < 0.f ? m.x : r.x; o.y = v.y < 0.f ? m.y : r.y; return o;
}
template <class Epi, class Sched, bool ALIGN_EPI = false, bool SP2 = false>
__device__ __forceinline__ void gemm_phase(PG8_LAS unsigned char* lds, const Gemm g, const Sched& S, const Epi& E) {
    int tid_ = threadIdx.x; asm volatile("" : "+v"(tid_));
    const int tid = tid_, wid = __builtin_amdgcn_readfirstlane(tid >> 6), lane = tid & 63, wr = wid >> 2, wc = wid & 3, fr = lane & 15, fq = lane >> 4;
    const int K = g.K, nt = K / BK;
    unsigned voffA[2], voffB[2];
#pragma unroll
    for (int i = 0; i < 2; ++i) { int R, C; stage_rc(tid * 16 + i * 8192, R, C); const int Rb = Epi::PERM ? ((R & ~31) + perm32(R & 31)) : R;
        voffA[i] = (unsigned)(R * K + C) * 2u; voffB[i] = (unsigned)(Rb * K + C) * 2u; }
    const size_t kstep = (size_t)(BK * 2);
    const size_t hstep = (size_t)HALF * K * 2;
    const size_t tstep = 2 * hstep;
    const unsigned ldsw = (unsigned)wid * 1024u;
    const int aoff = lds_byte(wr * 64 + fr, fq * 8), boff = lds_byte(wc * 32 + fr, fq * 8);
#define PG8_SA(b, h) (((b) * 2 + (h)) * HTB)
#define PG8_SB(b, h) ((4 + (b) * 2 + (h)) * HTB)
#define PG8_STAGE(bufoff, gbase, voff) do { _Pragma("unroll") for (int _i = 0; _i < 2; ++_i) \
        __builtin_amdgcn_global_load_lds((const unsigned*)((const char*)(gbase) + (voff)[_i]), (PG8_LAS unsigned*)(lds + (bufoff) + ldsw + _i * 8192), 16, 0, 0); } while (0)
#define PG8_LDA(dst, b, h) do { _Pragma("unroll") for (int m = 0; m < 4; ++m) _Pragma("unroll") for (int k = 0; k < 2; ++k) dst[m][k] = *(const PG8_LAS bf16x8*)(lds + PG8_SA(b, h) + aoff + m * 2048 + k * 1024); } while (0)
#define PG8_LDB(dst, b, h) do { _Pragma("unroll") for (int n = 0; n < 2; ++n) _Pragma("unroll") for (int k = 0; k < 2; ++k) dst[n][k] = *(const PG8_LAS bf16x8*)(lds + PG8_SB(b, h) + boff + n * 2048 + k * 1024); } while (0)
#define PG8_MMA(ai, bj, At, Bt) do { __builtin_amdgcn_s_setprio(1); _Pragma("unroll") for (int m = 0; m < 4; ++m) _Pragma("unroll") for (int n = 0; n < 2; ++n) _Pragma("unroll") for (int k = 0; k < 2; ++k) \
        acc[ai][bj][m][n] = __builtin_amdgcn_mfma_f32_16x16x32_bf16(Bt[n][k], At[m][k], acc[ai][bj][m][n], 0, 0, 0); __builtin_amdgcn_s_setprio(0); } while (0)
#define PG8_WAIT_V(n) asm volatile("s_waitcnt vmcnt(" #n ")" ::: "memory")
#define PG8_WAIT_L(n) asm volatile("s_waitcnt lgkmcnt(" #n ")" ::: "memory")
#define PG8_BAR __builtin_amdgcn_s_barrier()
#define PG8_SCHED __builtin_amdgcn_sched_barrier(0)
    Unit cur, nxt; int ui = 0;
    if (!S.next(0, cur)) return;
    f32x4 acc[2][2][4][2];
#pragma unroll
    for (int a = 0; a < 2; ++a)
#pragma unroll
        for (int b = 0; b < 2; ++b)
#pragma unroll
            for (int m = 0; m < 4; ++m)
#pragma unroll
                for (int n = 0; n < 2; ++n) acc[a][b][m][n] = (f32x4){0.f, 0.f, 0.f, 0.f};
    bf16x8 At[4][2], B0[2][2], B1[2][2];
    const char* cA = (const char*)g.A + (size_t)cur.pm * tstep; const char* cB = (const char*)g.Bt + (size_t)cur.pn * tstep;
    S.a_ready(cur);
    if constexpr (SP2) {
        PG8_STAGE(PG8_SB(0, 0), cB, voffB); PG8_STAGE(PG8_SB(0, 1), cB + hstep, voffB); PG8_STAGE(PG8_SA(0, 0), cA, voffA); PG8_STAGE(PG8_SA(0, 1), cA + hstep, voffA);
        if (wr == 1) PG8_BAR;
        PG8_WAIT_V(2); PG8_BAR;
        PG8_STAGE(PG8_SB(1, 0), cB + kstep, voffB); PG8_STAGE(PG8_SA(1, 0), cA + kstep, voffA); PG8_STAGE(PG8_SB(1, 1), cB + hstep + kstep, voffB);
        PG8_WAIT_V(6); PG8_BAR;
    } else {
        PG8_STAGE(PG8_SB(0, 0), cB, voffB); PG8_STAGE(PG8_SA(0, 0), cA, voffA); PG8_STAGE(PG8_SB(0, 1), cB + hstep, voffB); PG8_STAGE(PG8_SA(0, 1), cA + hstep, voffA);
        if (wr == 1) PG8_BAR;
        PG8_WAIT_V(4); PG8_BAR;
        PG8_STAGE(PG8_SB(1, 0), cB + kstep, voffB); PG8_STAGE(PG8_SA(1, 0), cA + kstep, voffA); PG8_STAGE(PG8_SB(1, 1), cB + hstep + kstep, voffB);
        PG8_WAIT_V(6); PG8_BAR;
    }
    for (;;) {
        const bool has_next = S.next(ui + 1, nxt);
        const char* nA = has_next ? (const char*)g.A + (size_t)nxt.pm * tstep : cA; const char* nB = has_next ? (const char*)g.Bt + (size_t)nxt.pn * tstep : cB;
        for (int t = 0; t < nt; t += 2) {
            const bool last = (t == nt - 2);
            const char* a1 = cA + (size_t)(t + 1) * kstep;
            const char* a2 = last ? nA : cA + (size_t)(t + 2) * kstep; const char* b2 = last ? nB : cB + (size_t)(t + 2) * kstep;
            const char* a3 = a2 + kstep; const char* b3 = b2 + kstep;
            if (last && has_next) S.a_ready(nxt);
            if constexpr (SP2) {
            PG8_LDB(B0, 0, 0); PG8_LDB(B1, 0, 1); PG8_SCHED; PG8_LDA(At, 0, 0); PG8_STAGE(PG8_SA(1, 1), a1 + hstep, voffA);
            PG8_WAIT_V(8); PG8_WAIT_L(0); PG8_BAR; PG8_MMA(0, 0, At, B0); PG8_MMA(0, 1, At, B1); PG8_BAR; PG8_SCHED;
            PG8_LDA(At, 0, 1); PG8_STAGE(PG8_SB(0, 0), b2, voffB); PG8_STAGE(PG8_SB(0, 1), b2 + hstep, voffB); PG8_STAGE(PG8_SA(0, 0), a2, voffA);
            PG8_WAIT_V(8); PG8_WAIT_L(0); PG8_BAR; PG8_MMA(1, 0, At, B0); PG8_MMA(1, 1, At, B1); PG8_BAR; PG8_SCHED;
            PG8_LDB(B0, 1, 0); PG8_LDB(B1, 1, 1); PG8_SCHED; PG8_LDA(At, 1, 0); PG8_STAGE(PG8_SA(0, 1), a2 + hstep, voffA);
            PG8_WAIT_V(8); PG8_WAIT_L(0); PG8_BAR; PG8_MMA(0, 0, At, B0); PG8_MMA(0, 1, At, B1); PG8_BAR; PG8_SCHED;
            PG8_LDA(At, 1, 1); PG8_STAGE(PG8_SB(1, 0), b3, voffB); PG8_STAGE(PG8_SB(1, 1), b3 + hstep, voffB); PG8_STAGE(PG8_SA(1, 0), a3, voffA);
            PG8_WAIT_V(8); PG8_WAIT_L(0); PG8_BAR; PG8_MMA(1, 0, At, B0); PG8_MMA(1, 1, At, B1); PG8_BAR; PG8_SCHED;
            } else {
            PG8_LDB(B0, 0, 0); PG8_SCHED; PG8_LDA(At, 0, 0); PG8_STAGE(PG8_SA(1, 1), a1 + hstep, voffA);
            PG8_WAIT_L(8); PG8_BAR; PG8_WAIT_L(0); PG8_MMA(0, 0, At, B0); PG8_BAR; PG8_SCHED;
            PG8_LDB(B1, 0, 1); PG8_STAGE(PG8_SB(0, 0), b2, voffB);
            PG8_BAR; PG8_WAIT_L(0); PG8_MMA(0, 1, At, B1); PG8_BAR;
            PG8_LDA(At, 0, 1); PG8_STAGE(PG8_SA(0, 0), a2, voffA);
            PG8_BAR; PG8_WAIT_L(0); PG8_MMA(1, 0, At, B0); PG8_BAR; PG8_SCHED;
            PG8_STAGE(PG8_SB(0, 1), b2 + hstep, voffB);
            PG8_WAIT_V(6); PG8_BAR; PG8_MMA(1, 1, At, B1); PG8_BAR;
            PG8_LDB(B0, 1, 0); PG8_SCHED; PG8_LDA(At, 1, 0); PG8_STAGE(PG8_SA(0, 1), a2 + hstep, voffA);
            PG8_WAIT_L(8); PG8_BAR; PG8_WAIT_L(0); PG8_MMA(0, 0, At, B0); PG8_BAR; PG8_SCHED;
            PG8_LDB(B1, 1, 1); PG8_STAGE(PG8_SB(1, 0), b3, voffB);
            PG8_BAR; PG8_WAIT_L(0); PG8_MMA(0, 1, At, B1); PG8_BAR;
            PG8_LDA(At, 1, 1); PG8_STAGE(PG8_SA(1, 0), a3, voffA);
            PG8_BAR; PG8_WAIT_L(0); PG8_MMA(1, 0, At, B0); PG8_BAR; PG8_SCHED;
            PG8_STAGE(PG8_SB(1, 1), b3 + hstep, voffB);
            PG8_WAIT_V(6); PG8_BAR; PG8_MMA(1, 1, At, B1); PG8_BAR;
            }
        }
        if constexpr (ALIGN_EPI) { if (wr == 0) PG8_BAR; }
        if constexpr (!Epi::AFTER_DRAIN) { E(acc, cur, wr, wc, fr, fq); S.done(cur); }
        if (!has_next) break;
#pragma unroll
        for (int a = 0; a < 2; ++a)
#pragma unroll
            for (int b = 0; b < 2; ++b)
#pragma unroll
                for (int m = 0; m < 4; ++m)
#pragma unroll
                    for (int n = 0; n < 2; ++n) acc[a][b][m][n] = (f32x4){0.f, 0.f, 0.f, 0.f};
        cur = nxt; cA = nA; cB = nB; ++ui;
        if constexpr (ALIGN_EPI) { if (wr == 1) PG8_BAR; }
    }
    PG8_WAIT_V(0);
    if constexpr (!ALIGN_EPI) { if (wr == 0) PG8_BAR; }
    PG8_BAR;
    if constexpr (Epi::AFTER_DRAIN) { E.fused(acc, cur, wr, wc, fr, fq, lds, wid, lane); S.done(cur); }
#undef PG8_SA
#undef PG8_SB
#undef PG8_STAGE
#undef PG8_LDA
#undef PG8_LDB
#undef PG8_MMA
#undef PG8_WAIT_V
#undef PG8_WAIT_L
#undef PG8_BAR
#undef PG8_SCHED
}
}

#ifndef MK_MB
#define MK_MB 4
#endif
#ifndef MK_N_LAUNCHES
#define MK_N_LAUNCHES 1
#endif
constexpr int MB = MK_MB;
constexpr int TT = 4096, D = 1024, M = MB * TT, DEPTH = 4, FF = 2816, FF2 = 5632, GW = 2048;
constexpr float EPS = 1e-6f;
constexpr int NWAVES = 8;
constexpr int NPH = 2 + 2 * 5 + 2 * 7 + 1;
#ifndef MK_PHM
#define MK_PHM 0xffff
#endif
constexpr int PHM = MK_PHM;

constexpr size_t MiB = 1u << 20;
constexpr size_t WS_CTL = 0, CTL_ZERO_BYTES = 2 * MiB;
constexpr size_t WS_MOD = 2 * MiB;
constexpr size_t WS_LB = WS_MOD + 512 * 1024;
constexpr size_t WS_CWP = WS_LB + 64 * 1024;
constexpr size_t WS_CBP = 3 * MiB;
constexpr size_t WS_BWG = 3 * MiB + 256 * 1024;
constexpr size_t WS_BWH = 3 * MiB + 512 * 1024;
constexpr size_t WS_BWU = 3 * MiB + 768 * 1024;
constexpr size_t WS_TAB = 4 * MiB + 256 * 1024;
constexpr int TB_NG = 0, TB_FG = 8192, TB_GN = 9216, TB_LNG = 11264, TB_LNB = 15360, TB_BS = 19456;
constexpr size_t WS_WSB = 4 * MiB + 512 * 1024;
constexpr size_t WS_SSP = 6 * MiB;
constexpr size_t WS_VSTP = 7 * MiB;
constexpr size_t WS_HALO = 11 * MiB;
constexpr size_t WS_DVEC = 17 * MiB;
constexpr size_t WS_WGIN = 18 * MiB, WS_WGOUT = 34 * MiB, WS_WHIN = 42 * MiB, WS_WHOUT = 58 * MiB, WS_WUP = 62 * MiB, WS_WDOWN = 106 * MiB;
constexpr size_t WS_XG = 128 * MiB;
constexpr size_t WS_R = 160 * MiB;
constexpr size_t R_U = 0, R_V = (size_t)M * GW * 2;
constexpr size_t R_G = 0;
constexpr size_t R_Q = 0, R_I = (size_t)M * D * 2, R_GO = 2 * (size_t)M * D * 2, R_LOGF = 3 * (size_t)M * D * 2, R_STATE = R_LOGF + (size_t)M * D * 4;
constexpr size_t WS_END = WS_R + R_STATE + (size_t)MB * 512 * 16384 * 2;
static_assert(MB != 4 || WS_END == 384 * MiB, "d_ws map");
static_assert(WS_BWU + 4 * 4 * 5632 * 4 <= WS_TAB && WS_TAB + 21504 * 4 <= WS_WSB && WS_WSB + 2 * 8 * 16384 * 2 <= WS_SSP && WS_CWP + 4 * 3 * 5632 * 4 <= WS_CBP && WS_CBP + 4 * 5632 * 4 <= WS_BWG && WS_BWG + 2 * 4 * 4096 * 4 <= WS_BWH && WS_BWH + 2 * 4 * 4096 * 4 <= WS_BWU && WS_MOD + 4 * 4 * 6144 * 4 <= WS_LB && WS_LB + 8192 <= WS_CWP, "small tables overlap");
static_assert(WS_SSP + (size_t)M * 16 <= WS_VSTP && WS_VSTP + (size_t)M * 32 * 8 <= WS_HALO && WS_HALO + (size_t)(M / 256) * 4 * 5632 * 4 <= WS_DVEC && WS_DVEC + (size_t)MB * 512 * 128 * 4 <= WS_WGIN && WS_WDOWN + 4 * 1024 * 2816 * 2 <= WS_XG && WS_XG + (size_t)M * 2048 <= WS_R, "d_ws map overlap");

constexpr int RING_BYTES = 131072;
constexpr int HL_OFF = RING_BYTES;
constexpr int MISC_OFF = HL_OFF + 8192;
constexpr int LDS_BYTES = 147456;

#define GAS __attribute__((address_space(1)))
#define LAS __attribute__((address_space(3)))
typedef unsigned short bf16;
typedef unsigned v4u __attribute__((ext_vector_type(4)));
typedef unsigned v2u __attribute__((ext_vector_type(2)));
typedef float f32x4 __attribute__((ext_vector_type(4)));
typedef float f32x2 __attribute__((ext_vector_type(2)));
typedef short bf16x8 __attribute__((ext_vector_type(8)));
typedef short s16x4 __attribute__((ext_vector_type(4)));
#define LDS_WAIT() asm volatile("s_waitcnt lgkmcnt(0)" ::: "memory")
#define VM_WAIT() asm volatile("s_waitcnt vmcnt(0)" ::: "memory")

__device__ __forceinline__ unsigned pk2(float lo, float hi) { return pg8::cvt_pk_bf16(lo, hi); }
__device__ __forceinline__ float bflo(unsigned w) { return __uint_as_float(w << 16); }
__device__ __forceinline__ float bfhi(unsigned w) { return __uint_as_float(w & 0xffff0000u); }
__device__ __forceinline__ float bf2f(bf16 v) { return __uint_as_float(((unsigned)v) << 16); }
__device__ __forceinline__ bf16 f2bf(float f) { return (bf16)(pk2(f, 0.f) & 0xffffu); }
__device__ __forceinline__ float fsigmoid(float v) { return 1.f / (1.f + __expf(-v)); }
__device__ __forceinline__ float fsilu(float v) { return v / (1.f + __expf(-v)); }
__device__ __forceinline__ f32x4 gelu4(f32x4 v) { const f32x2 a = pg8::gelu_pk((f32x2){v.x, v.y}), b = pg8::gelu_pk((f32x2){v.z, v.w}); return (f32x4){a.x, a.y, b.x, b.y}; }
__device__ __forceinline__ float wave_sum(float v) {
#pragma unroll
    for (int o = 1; o < 64; o <<= 1) v += __shfl_xor(v, o);
    return v;
}
__device__ __forceinline__ s16x4 trrd(const LAS unsigned char* p) { typedef short v4i16_t __attribute__((ext_vector_type(4)));
    return __builtin_bit_cast(s16x4, __builtin_amdgcn_ds_read_tr16_b64_v4i16((LAS v4i16_t*)p)); }
__device__ __forceinline__ bf16x8 cat8(s16x4 lo, s16x4 hi) { return (bf16x8){lo[0], lo[1], lo[2], lo[3], hi[0], hi[1], hi[2], hi[3]}; }
template <int CTRL> __device__ __forceinline__ float ror16(float v) { return __int_as_float(__builtin_amdgcn_update_dpp(0, __float_as_int(v), CTRL, 0xf, 0xf, false)); }
__device__ __forceinline__ int up_row(int n) { return n < FF ? (n >> 7) * 256 + (n & 127) : ((n - FF) >> 7) * 256 + 128 + ((n - FF) & 127); }

#define XB_TMO      128
#define XB_XCNT(j)  (256  + 64 * (j))
#define XB_XSUB(j)  (1280 + 64 * (j))
#define XB_XGEN(j)  (2304 + 64 * (j))
#define XB_TOP      3328
#define XB_TOPGEN   3392
#define XCD_BAR_WORDS 3456
#define XB_SPIN_CAP (1u << 18)

__device__ __forceinline__ unsigned xb_ld(unsigned* p)              { return __hip_atomic_load(p, __ATOMIC_RELAXED, __HIP_MEMORY_SCOPE_AGENT); }
__device__ __forceinline__ unsigned xb_add(unsigned* p, unsigned v) { return __hip_atomic_fetch_add(p, v, __ATOMIC_RELAXED, __HIP_MEMORY_SCOPE_AGENT); }
__device__ __forceinline__ unsigned xb_xcc_id() { return (unsigned)__builtin_amdgcn_s_getreg((3 << 11) | 20) & 0xFu; }
#define XB_SPIN(cond, bar) do { unsigned _sp = 0; while (cond) { __builtin_amdgcn_s_sleep(1); \
    if ((++_sp & 255u) == 0u) { if (xb_ld(&(bar)[XB_TMO])) break; if (_sp > XB_SPIN_CAP) { atomicAdd(&(bar)[XB_TMO], 1u); break; } } } } while (0)

struct XcdBarrier {
    unsigned* bar; unsigned x;
    volatile LAS unsigned* st;
};

__device__ __forceinline__ XcdBarrier xcd_barrier_post(unsigned* bar, volatile LAS unsigned* st) {
    XcdBarrier b; b.bar = bar; b.x = xb_xcc_id(); b.st = st;
    if (threadIdx.x == 0) (void)xb_add(&bar[XB_XCNT(b.x)], 1u);
    return b;
}
__device__ __forceinline__ void xcd_barrier_complete(unsigned* bar, unsigned x, unsigned& nloc, unsigned& nx) {
    const unsigned G = gridDim.x * gridDim.y * gridDim.z;
    unsigned sum, cnt, mine, sp = 0u;
    for (;;) {
        sum = 0u; cnt = 0u; mine = 0u;
#pragma unroll
        for (unsigned j = 0; j < 16; ++j) { const unsigned c = xb_ld(&bar[XB_XCNT(j)]); sum += c; cnt += (c > 0u) ? 1u : 0u; mine = (j == x) ? c : mine; }
        if (sum == G) break;
        __builtin_amdgcn_s_sleep(1);
        if ((++sp & 255u) == 0u) { if (xb_ld(&bar[XB_TMO])) break; if (sp > XB_SPIN_CAP) { atomicAdd(&bar[XB_TMO], 1u); break; } }
    }
    nloc = mine > 0u ? mine : 1u; nx = cnt > 0u ? cnt : 1u;
}

__device__ __forceinline__ void xcd_barrier(const XcdBarrier& b) {
    asm volatile("s_waitcnt vmcnt(0)" ::: "memory");
    __syncthreads();
    if (threadIdx.x == 0) {
        unsigned* bar = b.bar;
        __builtin_amdgcn_s_waitcnt(0);
        unsigned nloc = b.st[0], nx = b.st[1];
        if (nloc == 0u) { xcd_barrier_complete(bar, b.x, nloc, nx); b.st[0] = nloc; b.st[1] = nx; }
        const unsigned old = xb_add(&bar[XB_XSUB(b.x)], 1u);
        const unsigned gen = old / nloc;
        if (old + 1u == (gen + 1u) * nloc) {
            __builtin_amdgcn_fence(__ATOMIC_RELEASE, "agent");
            asm volatile("s_waitcnt vmcnt(0)" ::: "memory");
            const unsigned og = xb_add(&bar[XB_TOP], 1u);
            const unsigned tg = og / nx;
            if (og + 1u == (tg + 1u) * nx) xb_add(&bar[XB_TOPGEN], 1u);
            else XB_SPIN(xb_ld(&bar[XB_TOPGEN]) == tg, bar);
            __builtin_amdgcn_fence(__ATOMIC_ACQUIRE, "agent");
            xb_add(&bar[XB_XGEN(b.x)], 1u);
            asm volatile("s_waitcnt vmcnt(0)" ::: "memory");
        } else {
            XB_SPIN(xb_ld(&bar[XB_XGEN(b.x)]) == gen, bar);
            __builtin_amdgcn_fence(__ATOMIC_ACQUIRE, "agent");
            asm volatile("s_waitcnt vmcnt(0)" ::: "memory");
        }
    }
    __syncthreads();
}

struct Args { const float* in[20]; float* out; unsigned char* ws; int ph_lo, ph_hi, never, pad; };
struct Frame {
    LAS unsigned char* lds;
    volatile LAS unsigned* MISC;
    int tid, lane, wave, vcu, G;
    const float *x, *c, *gm_w_in, *gm_ln_g, *gm_ln_b, *gm_w_s, *gm_b_s, *gm_w_out, *hg_w_in, *hg_lb, *hg_gn_g, *hg_w_out, *ffn_w_up, *ffn_conv_w, *ffn_conv_b, *ffn_w_down, *norm_g, *ada_w, *ada_b, *final_g;
    float* out;
    unsigned char* ws;
    float *mod, *lb, *cwp, *cbp, *bwg, *bwh, *bwu, *ssp, *halo, *dvec, *tab; f32x2* vstp; bf16* wsb;
    bf16 *Wgin, *Wgout, *Whin, *Whout, *Wup, *Wdown, *XG, *R;
    __device__ __forceinline__ void bind(const Args& args, bool inputs) {
        GAS unsigned char* wg = (GAS unsigned char*)args.ws; GAS float* og = (GAS float*)args.out; const GAS float* xg0 = (const GAS float*)args.in[0];
        asm volatile("" : "+s"(wg), "+s"(og), "+s"(xg0));
        unsigned char* w = (unsigned char*)wg; float* o = (float*)og; const float* x0 = (const float*)xg0;
        ws = w; out = o; x = x0;
        if (inputs) { c = args.in[1]; gm_w_in = args.in[2]; gm_ln_g = args.in[3]; gm_ln_b = args.in[4]; gm_w_s = args.in[5]; gm_b_s = args.in[6]; gm_w_out = args.in[7];
            hg_w_in = args.in[8]; hg_lb = args.in[9]; hg_gn_g = args.in[10]; hg_w_out = args.in[11]; ffn_w_up = args.in[12]; ffn_conv_w = args.in[13]; ffn_conv_b = args.in[14];
            ffn_w_down = args.in[15]; norm_g = args.in[16]; ada_w = args.in[17]; ada_b = args.in[18]; final_g = args.in[19]; }
        mod = (float*)(w + WS_MOD); lb = (float*)(w + WS_LB); cwp = (float*)(w + WS_CWP); cbp = (float*)(w + WS_CBP); bwg = (float*)(w + WS_BWG); bwh = (float*)(w + WS_BWH); bwu = (float*)(w + WS_BWU);
        tab = (float*)(w + WS_TAB); wsb = (bf16*)(w + WS_WSB); ssp = (float*)(w + WS_SSP); vstp = (f32x2*)(w + WS_VSTP); halo = (float*)(w + WS_HALO); dvec = (float*)(w + WS_DVEC);
        Wgin = (bf16*)(w + WS_WGIN); Wgout = (bf16*)(w + WS_WGOUT); Whin = (bf16*)(w + WS_WHIN); Whout = (bf16*)(w + WS_WHOUT); Wup = (bf16*)(w + WS_WUP); Wdown = (bf16*)(w + WS_WDOWN);
        XG = (bf16*)(w + WS_XG); R = (bf16*)(w + WS_R);
    }
};

__device__ __forceinline__ float row_rstd(const float* ssp, int row) {
    const f32x4 s = *(const f32x4*)(ssp + (size_t)row * 4);
    return rsqrtf(((s.x + s.y) + (s.z + s.w)) * (1.f / 1024.f) + EPS);
}

struct EpiGin {
    static constexpr bool PERM = true, AFTER_DRAIN = false;
    const float* ssp; const float* bw; bf16* U; bf16* V; f32x2* vstp;
    __device__ __forceinline__ void operator()(f32x4 (&acc)[2][2][4][2], const pg8::Unit& u, int wr, int wc, int fr_, int fq_) const {
        int fr = fr_, fq = fq_; asm volatile("" : "+v"(fr), "+v"(fq));
        const int b = u.pm >> 4, col0 = u.pn * 256 + wc * 32 + 8 * fq, rowb = u.pm * 256 + wr * 64 + fr;
        const bool isv = u.pn >= 8; bf16* base = isv ? V : U; const int cc0 = (u.pn & 7) * 256 + wc * 32 + 8 * fq;
        f32x4 bv[2][2];
#pragma unroll
        for (int bj = 0; bj < 2; ++bj)
#pragma unroll
            for (int n = 0; n < 2; ++n) bv[bj][n] = *(const f32x4*)(bw + b * 4096 + col0 + bj * 128 + 4 * n);
#pragma unroll
        for (int ai = 0; ai < 2; ++ai)
#pragma unroll
            for (int m = 0; m < 4; ++m) {
                const int row = rowb + ai * 128 + m * 16; const float rs = row_rstd(ssp, row); float s = 0.f, q = 0.f;
#pragma unroll
                for (int bj = 0; bj < 2; ++bj) {
                    const f32x4 v0 = gelu4(acc[ai][bj][m][0] * rs + bv[bj][0]), v1 = gelu4(acc[ai][bj][m][1] * rs + bv[bj][1]);
                    v4u w; w.x = pk2(v0.x, v0.y); w.y = pk2(v0.z, v0.w); w.z = pk2(v1.x, v1.y); w.w = pk2(v1.z, v1.w);
                    *(v4u*)(base + (size_t)row * GW + cc0 + bj * 128) = w;
                    s += ((v0.x + v0.y) + (v0.z + v0.w)) + ((v1.x + v1.y) + (v1.z + v1.w));
                    q += ((v0.x * v0.x + v0.y * v0.y) + (v0.z * v0.z + v0.w * v0.w)) + ((v1.x * v1.x + v1.y * v1.y) + (v1.z * v1.z + v1.w * v1.w));
                }
                if (isv) { s += __shfl_xor(s, 16); s += __shfl_xor(s, 32); q += __shfl_xor(q, 16); q += __shfl_xor(q, 32);
                    if (fq == 0) vstp[(size_t)row * 32 + (u.pn - 8) * 4 + wc] = (f32x2){s, q}; }
            }
    }
};
struct EpiHin {
    static constexpr bool PERM = true, AFTER_DRAIN = false;
    const float* ssp; const float* bw; const float* lb; bf16* Q; bf16* I; bf16* GO; float* LOGF;
    __device__ __forceinline__ void operator()(f32x4 (&acc)[2][2][4][2], const pg8::Unit& u, int wr, int wc, int fr_, int fq_) const {
        int fr = fr_, fq = fq_; asm volatile("" : "+v"(fr), "+v"(fq));
        const int b = u.pm >> 4, col0 = u.pn * 256 + wc * 32 + 8 * fq, rowb = u.pm * 256 + wr * 64 + fr;
        const int type = u.pn >> 2, cc0 = (u.pn & 3) * 256 + wc * 32 + 8 * fq;
        f32x4 bv[2][2], lv[2][2];
#pragma unroll
        for (int bj = 0; bj < 2; ++bj)
#pragma unroll
            for (int n = 0; n < 2; ++n) { bv[bj][n] = *(const f32x4*)(bw + b * 4096 + col0 + bj * 128 + 4 * n); lv[bj][n] = *(const f32x4*)(lb + cc0 + bj * 128 + 4 * n); }
        bf16* ob = Q + (size_t)(type == 2 ? 1 : 0) * (size_t)(R_I / 2) + (size_t)(type == 3 ? 1 : 0) * (size_t)(R_GO / 2);
#pragma unroll
        for (int ai = 0; ai < 2; ++ai)
#pragma unroll
            for (int m = 0; m < 4; ++m) {
                const int row = rowb + ai * 128 + m * 16; const float rs = row_rstd(ssp, row);
#pragma unroll
                for (int bj = 0; bj < 2; ++bj) {
                    f32x4 v[2];
#pragma unroll
                    for (int n = 0; n < 2; ++n) v[n] = acc[ai][bj][m][n] * rs + bv[bj][n];
                    if (type == 1) {
#pragma unroll
                        for (int n = 0; n < 2; ++n) { f32x4 o;
#pragma unroll
                            for (int e = 0; e < 4; ++e) { const float z = v[n][e], l = lv[bj][n][e];
                                const float ls = fminf(z, 0.f) - __logf(1.f + __expf(-fabsf(z)));
                                const float f = l + (1.f - l) * fsigmoid(z);
                                o[e] = (l == 0.f) ? ls : __logf(f); }
                            *(f32x4*)(LOGF + (size_t)row * D + cc0 + bj * 128 + 4 * n) = o; }
                    } else {
                        if (type != 2) {
#pragma unroll
                            for (int n = 0; n < 2; ++n)
#pragma unroll
                                for (int e = 0; e < 4; ++e) v[n][e] = fsilu(v[n][e]); }
                        v4u w; w.x = pk2(v[0].x, v[0].y); w.y = pk2(v[0].z, v[0].w); w.z = pk2(v[1].x, v[1].y); w.w = pk2(v[1].z, v[1].w);
                        *(v4u*)(ob + (size_t)row * D + cc0 + bj * 128) = w;
                    }
                }
            }
    }
};
struct EpiOut {
    static constexpr bool PERM = true, AFTER_DRAIN = false;
    const float* xin; float* xout; const float* gate; bf16* XG; const float* ng; const float* scn; float* ssp; int write_xg; LAS float* hl;
    __device__ __forceinline__ void operator()(f32x4 (&acc)[2][2][4][2], const pg8::Unit& u, int wr, int wc, int fr_, int fq_) const {
        int fr = fr_, fq = fq_; asm volatile("" : "+v"(fr), "+v"(fq));
        const int b = u.pm >> 4, col0 = u.pn * 256 + wc * 32 + 8 * fq, rowb = u.pm * 256 + wr * 64 + fr;
        f32x4 gv[2][2], mv[2][2];
#pragma unroll
        for (int bj = 0; bj < 2; ++bj)
#pragma unroll
            for (int n = 0; n < 2; ++n) { const int c = col0 + bj * 128 + 4 * n; gv[bj][n] = *(const f32x4*)(gate + b * 6144 + c);
                mv[bj][n] = (f32x4){0.f, 0.f, 0.f, 0.f};
                if (write_xg) { const f32x4 g4 = *(const f32x4*)(ng + c), s4 = *(const f32x4*)(scn + b * 6144 + c); mv[bj][n] = g4 * (s4 + 1.f); } }
#pragma unroll
        for (int ai = 0; ai < 2; ++ai)
#pragma unroll
            for (int m = 0; m < 4; ++m) {
                const int row = rowb + ai * 128 + m * 16; float q = 0.f;
#pragma unroll
                for (int bj = 0; bj < 2; ++bj) {
                    f32x4 xn[2];
#pragma unroll
                    for (int n = 0; n < 2; ++n) { const size_t off = (size_t)row * D + col0 + bj * 128 + 4 * n;
                        xn[n] = *(const f32x4*)(xin + off) + gv[bj][n] * acc[ai][bj][m][n]; *(f32x4*)(xout + off) = xn[n];
                        q += (xn[n].x * xn[n].x + xn[n].y * xn[n].y) + (xn[n].z * xn[n].z + xn[n].w * xn[n].w); }
                    if (write_xg) { const f32x4 a = xn[0] * mv[bj][0], c = xn[1] * mv[bj][1];
                        v4u w; w.x = pk2(a.x, a.y); w.y = pk2(a.z, a.w); w.z = pk2(c.x, c.y); w.w = pk2(c.z, c.w);
                        *(v4u*)(XG + (size_t)row * D + col0 + bj * 128) = w; }
                }
                q += __shfl_xor(q, 16); q += __shfl_xor(q, 32);
                if (fq == 0) hl[(ai * 128 + wr * 64 + m * 16 + fr) * 4 + wc] = q;
            }
        LDS_WAIT(); __builtin_amdgcn_s_barrier(); asm volatile("" ::: "memory");
        { const int lane = fq * 16 + fr, rl = (wr * 4 + wc) * 32 + (lane & 31);
          if (lane < 32) { const f32x4 t = *(const LAS f32x4*)(hl + rl * 4); ssp[(size_t)(u.pm * 256 + rl) * 4 + u.pn] = (t.x + t.y) + (t.z + t.w); } }
        LDS_WAIT(); __builtin_amdgcn_s_barrier(); asm volatile("" ::: "memory");
    }
};
struct EpiUp {
    static constexpr bool PERM = true, AFTER_DRAIN = false;
    const float* ssp; const float* bw; const float* cw; const float* cb; bf16* G; float* halo; LAS float* hl;
    __device__ __forceinline__ void operator()(f32x4 (&acc)[2][2][4][2], const pg8::Unit& u, int wr, int wc, int fr_, int fq_) const {
        int fr = fr_, fq = fq_; asm volatile("" : "+v"(fr), "+v"(fq));
        const int lane = fq * 16 + fr;
        const int b = u.pm >> 4, col0 = u.pn * 256 + wc * 32 + 8 * fq, lc0 = wc * 32 + 8 * fq, rowb = u.pm * 256 + wr * 64 + fr;
        {   f32x4 bv[2][2];
#pragma unroll
            for (int bj = 0; bj < 2; ++bj)
#pragma unroll
                for (int n = 0; n < 2; ++n) bv[bj][n] = *(const f32x4*)(bw + b * FF2 + col0 + bj * 128 + 4 * n);
#pragma unroll
            for (int ai = 0; ai < 2; ++ai)
#pragma unroll
                for (int m = 0; m < 4; ++m) { const float rs = row_rstd(ssp, rowb + ai * 128 + m * 16);
#pragma unroll
                    for (int bj = 0; bj < 2; ++bj)
#pragma unroll
                        for (int n = 0; n < 2; ++n) acc[ai][bj][m][n] = acc[ai][bj][m][n] * rs + bv[bj][n];
                    asm volatile("" : "+v"(acc[ai][0][m][0]), "+v"(acc[ai][0][m][1]), "+v"(acc[ai][1][m][0]), "+v"(acc[ai][1][m][1])); }
        }
        if (fr >= 14) {
#pragma unroll
            for (int ai = 0; ai < 2; ++ai)
#pragma unroll
                for (int bj = 0; bj < 2; ++bj)
#pragma unroll
                    for (int n = 0; n < 2; ++n) *(LAS f32x4*)(hl + ((ai * 2 + wr) * 2 + (fr - 14)) * 256 + bj * 128 + lc0 + 4 * n) = acc[ai][bj][3][n];
            if (wr == 1) {
#pragma unroll
                for (int bj = 0; bj < 2; ++bj)
#pragma unroll
                    for (int n = 0; n < 2; ++n) *(f32x4*)(halo + ((size_t)u.pm * 4 + 2 + (fr - 14)) * FF2 + col0 + bj * 128 + 4 * n) = acc[1][bj][3][n]; }
        }
        if (fr < 2 && wr == 0) {
#pragma unroll
            for (int bj = 0; bj < 2; ++bj)
#pragma unroll
                for (int n = 0; n < 2; ++n) *(f32x4*)(halo + ((size_t)u.pm * 4 + fr) * FF2 + col0 + bj * 128 + 4 * n) = acc[0][bj][0][n]; }
        LDS_WAIT(); __builtin_amdgcn_s_barrier(); asm volatile("" ::: "memory");
#pragma unroll
        for (int n = 0; n < 2; ++n) {
#pragma unroll
            for (int bj = 0; bj < 2; ++bj) {
                asm volatile("" ::: "memory");
                const int c = col0 + bj * 128 + 4 * n;
                const f32x4 cbv = *(const f32x4*)(cb + c), w0 = *(const f32x4*)(cw + c), w1 = *(const f32x4*)(cw + FF2 + c), w2 = *(const f32x4*)(cw + 2 * FF2 + c);
#pragma unroll
                for (int ai = 0; ai < 2; ++ai) {
                    f32x4 tp, up;
                    if (ai == 0 && wr == 0) { tp = up = (f32x4){0.f, 0.f, 0.f, 0.f}; }
                    else { const int pg = ai * 2 + wr - 1;
                        tp = *(const LAS f32x4*)(hl + (pg * 2 + 1) * 256 + bj * 128 + lc0 + 4 * n);
                        up = *(const LAS f32x4*)(hl + (pg * 2 + (fr == 0 ? 0 : 1)) * 256 + bj * 128 + lc0 + 4 * n); }
#pragma unroll
                    for (int m = 0; m < 4; ++m) {
                        const f32x4 cur = acc[ai][bj][m][n]; f32x4 t, s;
#pragma unroll
                        for (int e = 0; e < 4; ++e) { t[e] = ror16<0x121>(cur[e]); s[e] = ror16<0x122>(cur[e]); }
                        const f32x4 p1 = fr >= 1 ? t : tp, p2 = fr >= 2 ? s : up;
                        acc[ai][bj][m][n] = cbv + w0 * p2 + w1 * p1 + w2 * cur; tp = t; up = s;
                        asm volatile("" : "+v"(acc[ai][bj][m][n]));
                    }
                }
            }
#pragma unroll
            for (int ai = 0; ai < 2; ++ai)
#pragma unroll
                for (int m = 0; m < 4; ++m) {
                    const f32x4 o = gelu4(acc[ai][0][m][n]) * acc[ai][1][m][n];
                    v2u w; w.x = pk2(o.x, o.y); w.y = pk2(o.z, o.w);
                    *(v2u*)(G + (size_t)(rowb + ai * 128 + m * 16) * FF + u.pn * 128 + lc0 + 4 * n) = w;
                }
        }
    }
};
__device__ __forceinline__ void ffn_fixup(Frame& F, int layer, int pm) {
    if ((pm & 15) == 0) return;
    const float* cw = F.cwp + (size_t)layer * 3 * FF2; const float* cb = F.cbp + (size_t)layer * FF2;
    const float* hp = F.halo + (size_t)(pm - 1) * 4 * FF2; const float* hc = F.halo + (size_t)pm * 4 * FF2; bf16* G = F.R + R_G / 2;
    for (int c = F.tid; c < FF; c += NWAVES * 64) {
        const int pgc = (c >> 7) * 256 + (c & 127); float y0[2], y1[2];
#pragma unroll
        for (int bj = 0; bj < 2; ++bj) { const int p = pgc + bj * 128; const float am2 = hp[2 * FF2 + p], am1 = hp[3 * FF2 + p], a0 = hc[p], a1 = hc[FF2 + p];
            const float w0 = cw[p], w1 = cw[FF2 + p], w2 = cw[2 * FF2 + p], bb = cb[p];
            y0[bj] = bb + w0 * am2 + w1 * am1 + w2 * a0; y1[bj] = bb + w0 * am1 + w1 * a0 + w2 * a1; }
        const f32x2 gg = pg8::gelu_pk((f32x2){y0[0], y1[0]});
        G[(size_t)(pm * 256) * FF + c] = f2bf(gg.x * y0[1]); G[(size_t)(pm * 256 + 1) * FF + c] = f2bf(gg.y * y1[1]);
    }
}

__device__ __forceinline__ void p0_transpose_item(const float* W, int K, int N, bf16* WT, bool perm, LAS float* scr, int item, int lane) {
    const int nblk = N / 32, kb = item / nblk, nb = item % nblk, k0 = 64 * kb, n0 = 32 * nb;
#pragma unroll 8
    for (int i = 0; i < 32; ++i) { const int kk = 2 * i + (lane >> 5); scr[kk * 33 + (lane & 31)] = W[(size_t)(k0 + kk) * N + n0 + (lane & 31)]; }
    LDS_WAIT(); asm volatile("" ::: "memory");
    const int c = lane & 7; const int r0 = perm ? up_row(n0) : n0;
#pragma unroll
    for (int j = 0; j < 4; ++j) { const int n = (lane >> 3) + 8 * j; const LAS float* s = scr + (8 * c) * 33 + n;
        v4u o; o.x = pk2(s[0 * 33], s[1 * 33]); o.y = pk2(s[2 * 33], s[3 * 33]); o.z = pk2(s[4 * 33], s[5 * 33]); o.w = pk2(s[6 * 33], s[7 * 33]);
        *(v4u*)(WT + (size_t)(r0 + n) * K + k0 + 8 * c) = o; }
    LDS_WAIT(); asm volatile("" ::: "memory");
}
__device__ __forceinline__ void p0a_phase(Frame& F) {
    LAS float* ldsf = (LAS float*)F.lds;
    constexpr int N_ADA = 4 * 48;
    constexpr int I_GIN = 16 * 128, I_GOUT = 32 * 32, I_HIN = 16 * 128, I_HOUT = 16 * 32, I_UP = 16 * 176, I_DOWN = 44 * 32;
    constexpr int NT = 2 * I_GIN + 2 * I_GOUT + 2 * I_HIN + 2 * I_HOUT + 4 * I_UP + 4 * I_DOWN;
    static_assert(NT % 8 == 0, "wave items");
    for (int it = F.vcu; it < N_ADA + NT / 8; it += F.G) {
        if (it < N_ADA) {
            const int layer = it / 48, nb = it % 48; LAS float* cond = ldsf; LAS float* red = ldsf + 4096;
            for (int i = F.tid; i < 4096; i += NWAVES * 64) cond[i] = fsilu(F.c[i]);
            __syncthreads();
            const int kg = F.tid >> 5, ln = F.tid & 31;
            const float* W = F.ada_w + (size_t)layer * 1024 * 6144 + nb * 128 + ln * 4;
            f32x4 a0 = {0.f, 0.f, 0.f, 0.f}, a1 = a0, a2 = a0, a3 = a0;
#pragma unroll 8
            for (int k = kg * 64; k < kg * 64 + 64; ++k) { const f32x4 w = *(const f32x4*)(W + (size_t)k * 6144); a0 += w * cond[k]; a1 += w * cond[1024 + k]; a2 += w * cond[2048 + k]; a3 += w * cond[3072 + k]; }
            *(LAS f32x4*)(red + (kg * 4 + 0) * 128 + ln * 4) = a0; *(LAS f32x4*)(red + (kg * 4 + 1) * 128 + ln * 4) = a1;
            *(LAS f32x4*)(red + (kg * 4 + 2) * 128 + ln * 4) = a2; *(LAS f32x4*)(red + (kg * 4 + 3) * 128 + ln * 4) = a3;
            __syncthreads();
            { const int b = F.tid >> 7, n = F.tid & 127; float s = 0.f;
#pragma unroll
              for (int k2 = 0; k2 < 16; ++k2) s += red[(k2 * 4 + b) * 128 + n];
              F.mod[(size_t)(layer * 4 + b) * 6144 + nb * 128 + n] = s + F.ada_b[layer * 6144 + nb * 128 + n]; }
            __syncthreads();
        } else {
            LAS float* scr = (LAS float*)(F.lds + F.wave * 16384);
            int r = (it - N_ADA) * 8 + F.wave;
            if (r < 2 * I_GIN) { const int j = r / I_GIN; p0_transpose_item(F.gm_w_in + (size_t)j * 1024 * 4096, 1024, 4096, F.Wgin + (size_t)j * 4096 * 1024, false, scr, r % I_GIN, F.lane); continue; } r -= 2 * I_GIN;
            if (r < 2 * I_GOUT) { const int j = r / I_GOUT; p0_transpose_item(F.gm_w_out + (size_t)j * 2048 * 1024, 2048, 1024, F.Wgout + (size_t)j * 1024 * 2048, false, scr, r % I_GOUT, F.lane); continue; } r -= 2 * I_GOUT;
            if (r < 2 * I_HIN) { const int j = r / I_HIN; p0_transpose_item(F.hg_w_in + (size_t)j * 1024 * 4096, 1024, 4096, F.Whin + (size_t)j * 4096 * 1024, false, scr, r % I_HIN, F.lane); continue; } r -= 2 * I_HIN;
            if (r < 2 * I_HOUT) { const int j = r / I_HOUT; p0_transpose_item(F.hg_w_out + (size_t)j * 1024 * 1024, 1024, 1024, F.Whout + (size_t)j * 1024 * 1024, false, scr, r % I_HOUT, F.lane); continue; } r -= 2 * I_HOUT;
            if (r < 4 * I_UP) { const int i = r / I_UP; p0_transpose_item(F.ffn_w_up + (size_t)i * 1024 * FF2, 1024, FF2, F.Wup + (size_t)i * FF2 * 1024, true, scr, r % I_UP, F.lane); continue; } r -= 4 * I_UP;
            { const int i = r / I_DOWN; p0_transpose_item(F.ffn_w_down + (size_t)i * FF * 1024, FF, 1024, F.Wdown + (size_t)i * 1024 * FF, false, scr, r % I_DOWN, F.lane); }
        }
    }
    if (F.vcu >= F.G - 9 && F.vcu < F.G - 1) {
        for (int mi = 0; mi < 2; ++mi) { const int mh = (F.vcu - (F.G - 9)) * 2 + mi;
            for (int e = F.tid; e < 16384; e += NWAVES * 64) { const int n = e >> 7, m = e & 127; const float v = F.gm_w_s[(size_t)mh * 16384 + e]; F.wsb[(size_t)mh * 16384 + e] = f2bf((n < 64 && m >= 64) ? 0.f : v); } }
    }
    if (F.vcu == F.G - 1) {
        for (int d = F.tid; d < 1024; d += NWAVES * 64) { const float l0 = F.hg_lb[d], l1 = F.hg_lb[1024 + d], mx = fmaxf(l0, l1), e0 = expf(l0 - mx), e1 = expf(l1 - mx); F.lb[d] = 0.f; F.lb[1024 + d] = e1 / (e0 + e1); }
        for (int i = F.tid; i < 8192; i += NWAVES * 64) F.tab[TB_NG + i] = F.norm_g[i];
        for (int i = F.tid; i < 1024; i += NWAVES * 64) F.tab[TB_FG + i] = F.final_g[i];
        for (int i = F.tid; i < 2048; i += NWAVES * 64) { F.tab[TB_GN + i] = F.hg_gn_g[i]; F.tab[TB_BS + i] = F.gm_b_s[i]; }
        for (int i = F.tid; i < 4096; i += NWAVES * 64) { F.tab[TB_LNG + i] = F.gm_ln_g[i]; F.tab[TB_LNB + i] = F.gm_ln_b[i]; }
        for (int i = F.tid; i < 4 * FF2; i += NWAVES * 64) { const int layer = i / FF2, n = i % FF2, p = up_row(n);
            F.cbp[layer * FF2 + p] = F.ffn_conv_b[i];
#pragma unroll
            for (int j = 0; j < 3; ++j) F.cwp[(size_t)(layer * 3 + j) * FF2 + p] = F.ffn_conv_w[(size_t)(layer * 3 + j) * FF2 + n]; }
    }
}
__device__ __forceinline__ void p0b_phase(Frame& F) {
    const int gw = F.vcu * NWAVES + F.wave, NGW = F.G * NWAVES, lane = F.lane;
    for (int mat = 0; mat < 8; ++mat) {
        const bf16* Wt; int nrows, layer, shoff; float* outp;
        if (mat < 2) { Wt = F.Wgin + (size_t)mat * 4096 * 1024; nrows = 4096; layer = 2 * mat; shoff = 0; outp = F.bwg + (size_t)mat * 4 * 4096; }
        else if (mat < 4) { Wt = F.Whin + (size_t)(mat - 2) * 4096 * 1024; nrows = 4096; layer = 2 * (mat - 2) + 1; shoff = 0; outp = F.bwh + (size_t)(mat - 2) * 4 * 4096; }
        else { Wt = F.Wup + (size_t)(mat - 4) * FF2 * 1024; nrows = FF2; layer = mat - 4; shoff = 3072; outp = F.bwu + (size_t)(mat - 4) * 4 * FF2; }
        f32x4 sh[4][4];
#pragma unroll
        for (int b = 0; b < 4; ++b) { const float* sp = F.mod + (size_t)(layer * 4 + b) * 6144 + shoff + 8 * lane;
            sh[b][0] = *(const f32x4*)sp; sh[b][1] = *(const f32x4*)(sp + 4); sh[b][2] = *(const f32x4*)(sp + 512); sh[b][3] = *(const f32x4*)(sp + 516); }
        for (int n = gw; n < nrows; n += NGW) {
            const v4u w0 = *(const v4u*)(Wt + (size_t)n * 1024 + 8 * lane), w1 = *(const v4u*)(Wt + (size_t)n * 1024 + 512 + 8 * lane);
            const f32x4 f0 = {bflo(w0.x), bfhi(w0.x), bflo(w0.y), bfhi(w0.y)}, f1 = {bflo(w0.z), bfhi(w0.z), bflo(w0.w), bfhi(w0.w)};
            const f32x4 f2 = {bflo(w1.x), bfhi(w1.x), bflo(w1.y), bfhi(w1.y)}, f3 = {bflo(w1.z), bfhi(w1.z), bflo(w1.w), bfhi(w1.w)};
            float r[4];
#pragma unroll
            for (int b = 0; b < 4; ++b) { const f32x4 t = sh[b][0] * f0 + sh[b][1] * f1 + sh[b][2] * f2 + sh[b][3] * f3; r[b] = wave_sum((t.x + t.y) + (t.z + t.w)); }
            if (lane == 0) {
#pragma unroll
                for (int b = 0; b < 4; ++b) outp[(size_t)b * nrows + n] = r[b]; }
        }
    }
    for (int m = gw; m < M; m += NGW) {
        const int b = m >> 12; const float* xr = F.x + (size_t)m * D; const float* sc = F.mod + (size_t)(0 * 4 + b) * 6144 + 1024; float ss = 0.f;
#pragma unroll
        for (int j = 0; j < 4; ++j) { const int c = 4 * lane + 256 * j; const f32x4 v = *(const f32x4*)(xr + c), g4 = *(const f32x4*)(F.tab + TB_NG + c), s4 = *(const f32x4*)(sc + c);
            ss += (v.x * v.x + v.y * v.y) + (v.z * v.z + v.w * v.w); const f32x4 o = v * g4 * (s4 + 1.f);
            v2u w; w.x = pk2(o.x, o.y); w.y = pk2(o.z, o.w); *(v2u*)(F.XG + (size_t)m * D + c) = w; }
        ss = wave_sum(ss);
        if (lane < 4) F.ssp[(size_t)m * 4 + lane] = lane == 0 ? ss : 0.f;
    }
}
__device__ __forceinline__ void sg_phase(Frame& F, int j) {
    LAS unsigned char* L = F.lds;
    constexpr int WL_OFF = 0, WL_S = 272, VL_OFF = 128 * 272, VL_S = 528, ST_OFF = VL_OFF + 128 * 528;
    const bf16* wsb = F.wsb + (size_t)j * 8 * 128 * 128; const float* bs = F.tab + TB_BS + j * 8 * 128; const float* lng = F.tab + TB_LNG + j * GW; const float* lnb = F.tab + TB_LNB + j * GW;
    bf16* U = F.R + R_U / 2; const bf16* V = F.R + R_V / 2;
    const int tid = F.tid, l = F.lane, w = F.wave, g = l >> 4, c15 = l & 15, qq = c15 >> 2, p4 = l & 3;
    LAS f32x2* ST = (LAS f32x2*)(L + ST_OFF);
    for (int it = F.vcu; it < (M / 128) * 8; it += F.G) {
        const int tb = it >> 3, h = it & 7; const size_t tok0 = (size_t)tb * 128;
        if (tid < 128) { const f32x2* p = F.vstp + (tok0 + tid) * 32; float s = 0.f, q = 0.f;
#pragma unroll
            for (int i = 0; i < 32; ++i) { const f32x2 v = p[i]; s += v.x; q += v.y; }
            const float mu = s * (1.f / 2048.f), var = q * (1.f / 2048.f) - mu * mu; ST[tid] = (f32x2){mu, rsqrtf(var + EPS)}; }
        { const int n = tid >> 2, c0 = (tid & 3) * 32; const bf16* wp = wsb + ((size_t)(h * 128 + n) * 128 + c0);
#pragma unroll
          for (int i = 0; i < 4; ++i) *(LAS v4u*)(L + WL_OFF + n * WL_S + (c0 + 8 * i) * 2) = *(const v4u*)(wp + 8 * i); }
        __syncthreads();
        { const int p = tid & 31, r0 = tid >> 5; const int ch = h * 256 + 8 * p;
          const f32x4 g0 = *(const f32x4*)(lng + ch), g1 = *(const f32x4*)(lng + ch + 4), b0 = *(const f32x4*)(lnb + ch), b1 = *(const f32x4*)(lnb + ch + 4);
#pragma unroll
          for (int i = 0; i < 8; ++i) { const int m = r0 + 16 * i; const v4u raw = *(const v4u*)(V + (tok0 + m) * GW + ch); const f32x2 st = ST[m];
              f32x4 a = {bflo(raw.x), bfhi(raw.x), bflo(raw.y), bfhi(raw.y)}, b = {bflo(raw.z), bfhi(raw.z), bflo(raw.w), bfhi(raw.w)};
              a = (a - st.x) * st.y * g0 + b0; b = (b - st.x) * st.y * g1 + b1;
              v4u o; o.x = pk2(a.x, a.y); o.y = pk2(a.z, a.w); o.z = pk2(b.x, b.y); o.w = pk2(b.z, b.w);
              *(LAS v4u*)(L + VL_OFF + m * VL_S + p * 16) = o; } }
        __syncthreads();
        f32x4 acc[2][8];
#pragma unroll
        for (int db = 0; db < 2; ++db)
#pragma unroll
            for (int nb = 0; nb < 8; ++nb) acc[db][nb] = (f32x4){0.f, 0.f, 0.f, 0.f};
#pragma unroll
        for (int ks = 0; ks < 4; ++ks) {
            bf16x8 a[2];
#pragma unroll
            for (int db = 0; db < 2; ++db) { const LAS unsigned char* ap = L + VL_OFF + (32 * ks + 8 * g + qq) * VL_S + (32 * w + 16 * db + 4 * p4) * 2;
                a[db] = cat8(trrd(ap), trrd(ap + 4 * VL_S)); }
#pragma unroll
            for (int nb = 0; nb < 8; ++nb) {
                if (ks >= 2 && nb < 4) continue;
                const bf16x8 bfr = *(const LAS bf16x8*)(L + WL_OFF + (16 * nb + c15) * WL_S + (32 * ks + 8 * g) * 2);
#pragma unroll
                for (int db = 0; db < 2; ++db) acc[db][nb] = __builtin_amdgcn_mfma_f32_16x16x32_bf16(a[db], bfr, acc[db][nb], 0, 0, 0);
            }
        }
#pragma unroll
        for (int nb = 0; nb < 8; ++nb) { const int n = 16 * nb + c15; const float bsv = bs[h * 128 + n];
#pragma unroll
            for (int db = 0; db < 2; ++db) { bf16* up = U + (tok0 + n) * GW + h * 256 + 32 * w + 16 * db + 4 * g; const v2u uu = *(const v2u*)up;
                const f32x4 s = acc[db][nb] + bsv; v2u o; o.x = pk2(bflo(uu.x) * s.x, bfhi(uu.x) * s.y); o.y = pk2(bflo(uu.y) * s.z, bfhi(uu.y) * s.w); *(v2u*)up = o; } }
        __syncthreads();
    }
}
__device__ __forceinline__ void s1_phase(Frame& F) {
    LAS unsigned char* VR = F.lds; constexpr int VS = 272;
    const bf16* I = F.R + R_I / 2; const float* LOGF = (const float*)((const unsigned char*)F.R + R_LOGF); bf16* STATE = F.R + R_STATE / 2;
    const int tid = F.tid, l = F.lane, w = F.wave, g = l >> 4, c15 = l & 15, qq = c15 >> 2, p4 = l & 3;
    for (int un = F.vcu; un < MB * 512; un += F.G) {
        const int bh = un >> 6, c = un & 63, b = bh >> 3, h = bh & 7; const size_t t0 = (size_t)b * TT + c * 64;
        { const int p = tid & 15, j0 = tid >> 4;
#pragma unroll
          for (int i = 0; i < 2; ++i) { const int jt = j0 + 32 * i; *(LAS v4u*)(VR + jt * VS + p * 16) = *(const v4u*)(I + (t0 + jt) * D + h * 128 + 8 * p); } }
        const float* lf = LOGF + (t0 + 16 * g) * D + h * 128 + 16 * w + c15;
        float cum[16], kv[16], run = 0.f;
#pragma unroll
        for (int i = 0; i < 16; ++i) { const float x = lf[(size_t)i * D]; run += x; cum[i] = run; kv[i] = 1.f - __expf(x); }
        const float t0q = __shfl(run, c15), t1q = __shfl(run, c15 + 16), t2q = __shfl(run, c15 + 32), t3q = __shfl(run, c15 + 48);
        const float off = (g > 0 ? t0q : 0.f) + (g > 1 ? t1q : 0.f) + (g > 2 ? t2q : 0.f), last = (t0q + t1q) + (t2q + t3q);
        bf16x8 af[2];
#pragma unroll
        for (int ks = 0; ks < 2; ++ks) { float e[8];
#pragma unroll
            for (int jj = 0; jj < 8; ++jj) e[jj] = kv[8 * ks + jj] * __expf(last - off - cum[8 * ks + jj]);
            const v4u pk = {pk2(e[0], e[1]), pk2(e[2], e[3]), pk2(e[4], e[5]), pk2(e[6], e[7])}; af[ks] = __builtin_bit_cast(bf16x8, pk); }
        if (g == 0) F.dvec[(size_t)un * 128 + 16 * w + c15] = __expf(last);
        __syncthreads();
        f32x4 acc[8];
#pragma unroll
        for (int vb = 0; vb < 8; ++vb) acc[vb] = (f32x4){0.f, 0.f, 0.f, 0.f};
#pragma unroll
        for (int ks = 0; ks < 2; ++ks)
#pragma unroll
            for (int vb = 0; vb < 8; ++vb) { const LAS unsigned char* bp = VR + (16 * g + 8 * ks + qq) * VS + (16 * vb + 4 * p4) * 2;
                acc[vb] = __builtin_amdgcn_mfma_f32_16x16x32_bf16(af[ks], cat8(trrd(bp), trrd(bp + 4 * VS)), acc[vb], 0, 0, 0); }
#pragma unroll
        for (int vb = 0; vb < 8; ++vb) { v2u o; o.x = pk2(acc[vb].x, acc[vb].y); o.y = pk2(acc[vb].z, acc[vb].w);
            *(v2u*)(STATE + (size_t)un * 16384 + ((w * 8 + vb) * 64 + l) * 4) = o; }
        __syncthreads();
    }
}
__device__ __forceinline__ void s2_phase(Frame& F) {
    bf16* STATE = F.R + R_STATE / 2;
    for (int gid = F.vcu * (NWAVES * 64) + F.tid; gid < MB * 8 * 4096; gid += F.G * NWAVES * 64) {
        const int bh = gid >> 12, e4 = gid & 4095, w = e4 >> 9, l = e4 & 63, k0 = 16 * w + 4 * (l >> 4);
        f32x4 s = {0.f, 0.f, 0.f, 0.f};
        for (int c0 = 0; c0 < 64; c0 += 8) {
            v2u u[8]; f32x4 d[8];
#pragma unroll
            for (int i = 0; i < 8; ++i) { const size_t un = (size_t)bh * 64 + c0 + i; u[i] = *(const v2u*)(STATE + un * 16384 + e4 * 4); d[i] = *(const f32x4*)(F.dvec + un * 128 + k0); }
#pragma unroll
            for (int i = 0; i < 8; ++i) { const size_t un = (size_t)bh * 64 + c0 + i; v2u o; o.x = pk2(s.x, s.y); o.y = pk2(s.z, s.w); *(v2u*)(STATE + un * 16384 + e4 * 4) = o;
                const f32x4 uf = {bflo(u[i].x), bfhi(u[i].x), bflo(u[i].y), bfhi(u[i].y)}; s = d[i] * s + uf; }
        }
    }
}
__device__ __forceinline__ void s3_phase(Frame& F, int j) {
    LAS unsigned char* L = F.lds; constexpr int RS = 272, PS = 144;
    constexpr int QP = 0, QE = 17408, KP = 34816, VRO = 78336, PL = 95744, TOT = 104960, SS = 107008;
    bf16* Q = F.R + R_Q / 2; const bf16* I = F.R + R_I / 2; const bf16* GO = F.R + R_GO / 2; const float* LOGF = (const float*)((const unsigned char*)F.R + R_LOGF); const bf16* STATE = F.R + R_STATE / 2;
    const float* gn = F.tab + TB_GN + j * D;
    const int tid = F.tid, l = F.lane, w = F.wave, g = l >> 4, c15 = l & 15, qq = c15 >> 2, p4 = l & 3;
    LAS float* tot = (LAS float*)(L + TOT); LAS float* ssl = (LAS float*)(L + SS);
    for (int un = F.vcu; un < MB * 512; un += F.G) {
        const int bh = un >> 6, c = un & 63, b = bh >> 3, h = bh & 7; const size_t t0 = (size_t)b * TT + c * 64;
        const int qg = tid >> 7, k = tid & 127;
        float cl[16], qv[16], kvv[16];
        { const float* lf = LOGF + (t0 + 16 * qg) * D + h * 128 + k; const bf16* qp = Q + (t0 + 16 * qg) * D + h * 128 + k; float run = 0.f;
#pragma unroll
          for (int i = 0; i < 16; ++i) { const float x = lf[(size_t)i * D]; run += x; cl[i] = run; kvv[i] = 1.f - __expf(x); qv[i] = bf2f(qp[(size_t)i * D]); }
          tot[qg * 128 + k] = run; }
        { const int p = tid & 15, j0 = tid >> 4;
#pragma unroll
          for (int i = 0; i < 2; ++i) { const int jt = j0 + 32 * i; *(LAS v4u*)(L + VRO + jt * RS + p * 16) = *(const v4u*)(I + (t0 + jt) * D + h * 128 + 8 * p); } }
        __syncthreads();
        { const float tq0 = tot[k], tq1 = tot[128 + k], tq2 = tot[256 + k];
          const float off = (qg > 0 ? tq0 : 0.f) + (qg > 1 ? tq1 : 0.f) + (qg > 2 ? tq2 : 0.f);
          const int kperm = 32 * (k >> 5) + 8 * ((k >> 2) & 3) + 4 * ((k >> 4) & 1) + (k & 3);
#pragma unroll
          for (int i = 0; i < 16; ++i) { const int tok = 16 * qg + i;
              *(LAS bf16*)(L + QP + tok * RS + k * 2) = f2bf(qv[i] * __expf(cl[i]));
              *(LAS bf16*)(L + QE + tok * RS + kperm * 2) = f2bf(qv[i] * __expf(off + cl[i]));
#pragma unroll
              for (int a = 0; a < 4; ++a) { if (a < qg) continue;
                  float ex = fminf(-cl[i], 80.f);
                  if (a > qg) { float r = (qg == 0 ? tq0 : (qg == 1 ? tq1 : tq2)); if (a > qg + 1) r += (qg == 0 ? tq1 : tq2); if (a > qg + 2) r += tq2; ex = r - cl[i]; }
                  const int kpb = a == 0 ? 0 : (a == 1 ? 16 : (a == 2 ? 48 : 96));
                  *(LAS bf16*)(L + KP + (kpb + tok) * RS + k * 2) = f2bf(kvv[i] * __expf(ex)); } } }
        __syncthreads();
#pragma unroll
        for (int rep = 0; rep < 2; ++rep) {
            const int idx = w + 8 * rep; if (idx >= 10) break;
            const int a = idx == 0 ? 0 : (idx < 3 ? 1 : (idx < 6 ? 2 : 3)), bb = idx - (a == 0 ? 0 : (a == 1 ? 1 : (a == 2 ? 3 : 6)));
            const int kpb = a == 0 ? 0 : (a == 1 ? 16 : (a == 2 ? 48 : 96));
            f32x4 sc = {0.f, 0.f, 0.f, 0.f};
#pragma unroll
            for (int ks = 0; ks < 4; ++ks) { const bf16x8 A = *(const LAS bf16x8*)(L + QP + (16 * a + c15) * RS + (32 * ks + 8 * g) * 2), B = *(const LAS bf16x8*)(L + KP + (kpb + 16 * bb + c15) * RS + (32 * ks + 8 * g) * 2);
                sc = __builtin_amdgcn_mfma_f32_16x16x32_bf16(A, B, sc, 0, 0, 0); }
#pragma unroll
            for (int r = 0; r < 4; ++r) { const int i = 4 * g + r; const float v = (a == bb && c15 > i) ? 0.f : sc[r]; *(LAS bf16*)(L + PL + (16 * a + i) * PS + (16 * bb + c15) * 2) = f2bf(v); }
        }
        if (w == 2 || w == 3) { const int a = w == 2 ? 0 : 2, bb = a + 1;
#pragma unroll
            for (int r = 0; r < 4; ++r) *(LAS bf16*)(L + PL + (16 * a + 4 * g + r) * PS + (16 * bb + c15) * 2) = (bf16)0; }
        __syncthreads();
        f32x4 o[4];
#pragma unroll
        for (int a = 0; a < 4; ++a) o[a] = (f32x4){0.f, 0.f, 0.f, 0.f};
        { bf16x8 vf[2];
#pragma unroll
          for (int ks = 0; ks < 2; ++ks) { const LAS unsigned char* bp = L + VRO + (32 * ks + 8 * g + qq) * RS + (16 * w + 4 * p4) * 2; vf[ks] = cat8(trrd(bp), trrd(bp + 4 * RS)); }
#pragma unroll
          for (int a = 0; a < 4; ++a)
#pragma unroll
              for (int ks = 0; ks < 2; ++ks) { if (a < 2 && ks == 1) continue;
                  const bf16x8 A = *(const LAS bf16x8*)(L + PL + (16 * a + c15) * PS + (32 * ks + 8 * g) * 2); o[a] = __builtin_amdgcn_mfma_f32_16x16x32_bf16(A, vf[ks], o[a], 0, 0, 0); } }
#pragma unroll
        for (int kk = 0; kk < 4; ++kk) {
            const v2u lo = *(const v2u*)(STATE + (size_t)un * 16384 + (((2 * kk) * 8 + w) * 64 + l) * 4), hi = *(const v2u*)(STATE + (size_t)un * 16384 + (((2 * kk + 1) * 8 + w) * 64 + l) * 4);
            const v4u sv = {lo.x, lo.y, hi.x, hi.y}; const bf16x8 sf = __builtin_bit_cast(bf16x8, sv);
#pragma unroll
            for (int a = 0; a < 4; ++a) { const bf16x8 A = *(const LAS bf16x8*)(L + QE + (16 * a + c15) * RS + (32 * kk + 8 * g) * 2); o[a] = __builtin_amdgcn_mfma_f32_16x16x32_bf16(A, sf, o[a], 0, 0, 0); }
        }
#pragma unroll
        for (int a = 0; a < 4; ++a)
#pragma unroll
            for (int r = 0; r < 4; ++r) { float sq = o[a][r] * o[a][r]; sq += __shfl_xor(sq, 1); sq += __shfl_xor(sq, 2); sq += __shfl_xor(sq, 4); sq += __shfl_xor(sq, 8);
                if (c15 == 0) ssl[(16 * a + 4 * g + r) * 8 + w] = sq; }
        __syncthreads();
        { const int col = h * 128 + 16 * w + c15; const float gnv = gn[col];
#pragma unroll
          for (int a = 0; a < 4; ++a)
#pragma unroll
              for (int r = 0; r < 4; ++r) { const int i = 16 * a + 4 * g + r; const f32x4 s0 = *(const LAS f32x4*)(ssl + i * 8), s1 = *(const LAS f32x4*)(ssl + i * 8 + 4);
                  const float rstd = rsqrtf((((s0.x + s0.y) + (s0.z + s0.w)) + ((s1.x + s1.y) + (s1.z + s1.w))) * (1.f / 128.f) + EPS);
                  const size_t off = (t0 + i) * D + col; Q[off] = f2bf(o[a][r] * rstd * gnv * bf2f(GO[off])); } }
        __syncthreads();
    }
}
__device__ __forceinline__ void final_phase(Frame& F) {
    const int gw = F.vcu * NWAVES + F.wave, NGW = F.G * NWAVES, lane = F.lane;
    for (int m = gw; m < M; m += NGW) { const float rs = row_rstd(F.ssp, m); float* xr = F.out + (size_t)m * D;
#pragma unroll
        for (int j = 0; j < 4; ++j) { const int c = 4 * lane + 256 * j; const f32x4 v = *(const f32x4*)(xr + c), g4 = *(const f32x4*)(F.tab + TB_FG + c); *(f32x4*)(xr + c) = v * rs * g4; } }
}

__global__ void __launch_bounds__(NWAVES * 64, 2) mk_fwd(Args args) {
    extern __shared__ __attribute__((aligned(16))) unsigned char lds[];
    Frame F;
    F.lds = (LAS unsigned char*)lds; F.MISC = (volatile LAS unsigned*)(F.lds + MISC_OFF);
    F.tid = threadIdx.x; F.lane = F.tid & 63; F.wave = __builtin_amdgcn_readfirstlane(F.tid >> 6);
    F.G = gridDim.x; { const int bx = blockIdx.x; F.vcu = (F.G % 8 == 0) ? (bx % 8) * (F.G / 8) + bx / 8 : bx; }
    unsigned char* ws = args.ws;
    for (int u = F.tid; u < (LDS_BYTES - MISC_OFF) / 4; u += NWAVES * 64) ((LAS unsigned*)(F.lds + MISC_OFF))[u] = 0u;
    __syncthreads();
    const int lo = args.ph_lo, hi = args.ph_hi;
    XcdBarrier bar; bar.bar = (unsigned*)(ws + WS_CTL) + 4096; bar.x = 0; bar.st = nullptr;
    if (hi - lo > 1) bar = xcd_barrier_post((unsigned*)(ws + WS_CTL) + 4096, F.MISC + 8);
    if (args.never) cooperative_groups::this_grid().sync();
    int ph = 0;
#define PH_BEGIN if (ph >= lo && ph < hi) { { int t_ = threadIdx.x; asm volatile("" : "+v"(t_)); F.tid = t_; F.lane = t_ & 63; F.bind(args, ph < 2); }
#define PH_END   if (ph + 1 < hi) xcd_barrier(bar); } ++ph;
    LAS float* hl = (LAS float*)(F.lds + HL_OFF);

    PH_BEGIN if (PHM & 1) p0a_phase(F); PH_END
    PH_BEGIN if (PHM & 2) p0b_phase(F); PH_END
    for (int i = 0; i < DEPTH; ++i) {
        const int j = i >> 1;
#define modl (F.mod + (size_t)i * 4 * 6144)
#define xin_mix ((i == 0) ? F.x : F.out)
        if ((i & 1) == 0) {
            PH_BEGIN if (PHM & 4) { pg8::Gemm gm{F.XG, F.Wgin + (size_t)j * 4096 * 1024, M, 4096, 1024}; pg8::StaticOrder S; S.init(M, 4096, F.G, (int)blockIdx.x);
                EpiGin E{F.ssp, F.bwg + (size_t)j * 4 * 4096, F.R + R_U / 2, F.R + R_V / 2, F.vstp};
                pg8::gemm_phase<EpiGin, pg8::StaticOrder, true, true>(F.lds, gm, S, E); } PH_END
            PH_BEGIN if (PHM & 8) sg_phase(F, j); PH_END
            PH_BEGIN if (PHM & 16) { pg8::Gemm gm{F.R + R_U / 2, F.Wgout + (size_t)j * 1024 * 2048, M, 1024, 2048}; pg8::StaticOrder S; S.init(M, 1024, F.G, (int)blockIdx.x);
                EpiOut E{xin_mix, F.out, modl + 2048, F.XG, F.tab + TB_NG + (i * 2 + 1) * 1024, modl + 4096, F.ssp, 1, hl};
                pg8::gemm_phase<EpiOut, pg8::StaticOrder, true, true>(F.lds, gm, S, E); } PH_END
        } else {
            PH_BEGIN if (PHM & 32) { pg8::Gemm gm{F.XG, F.Whin + (size_t)j * 4096 * 1024, M, 4096, 1024}; pg8::StaticOrder S; S.init(M, 4096, F.G, (int)blockIdx.x);
                EpiHin E{F.ssp, F.bwh + (size_t)j * 4 * 4096, F.lb + j * 1024, F.R + R_Q / 2, F.R + R_I / 2, F.R + R_GO / 2, (float*)((unsigned char*)F.R + R_LOGF)};
                pg8::gemm_phase<EpiHin, pg8::StaticOrder, true, true>(F.lds, gm, S, E); } PH_END
            PH_BEGIN if (PHM & 64) s1_phase(F); PH_END
            PH_BEGIN if (PHM & 128) s2_phase(F); PH_END
            PH_BEGIN if (PHM & 256) s3_phase(F, j); PH_END
            PH_BEGIN if (PHM & 512) { pg8::Gemm gm{F.R + R_Q / 2, F.Whout + (size_t)j * 1024 * 1024, M, 1024, 1024}; pg8::StaticOrder S; S.init(M, 1024, F.G, (int)blockIdx.x);
                EpiOut E{xin_mix, F.out, modl + 2048, F.XG, F.tab + TB_NG + (i * 2 + 1) * 1024, modl + 4096, F.ssp, 1, hl};
                pg8::gemm_phase<EpiOut, pg8::StaticOrder, true, true>(F.lds, gm, S, E); } PH_END
        }
        PH_BEGIN if (PHM & 1024) { pg8::Gemm gm{F.XG, F.Wup + (size_t)i * FF2 * 1024, M, FF2, 1024}; pg8::StaticOrder S; S.init(M, FF2, F.G, (int)blockIdx.x);
            EpiUp E{F.ssp, F.bwu + (size_t)i * 4 * FF2, F.cwp + (size_t)i * 3 * FF2, F.cbp + (size_t)i * FF2, F.R + R_G / 2, F.halo, hl};
            pg8::gemm_phase<EpiUp, pg8::StaticOrder, true, MK_SP2_UP>(F.lds, gm, S, E); } PH_END
        PH_BEGIN if (PHM & 2048) { pg8::Gemm gm{F.R + R_G / 2, F.Wdown + (size_t)i * 1024 * FF, M, 1024, FF}; pg8::StaticOrder S; S.init(M, 1024, F.G, (int)blockIdx.x);
            { pg8::Unit uu; for (int k = 0; S.next(k, uu); ++k) if (uu.pn == 0 || true) ffn_fixup(F, i, uu.pm); VM_WAIT(); __syncthreads(); }
            const int nl = (i + 1 < DEPTH) ? i + 1 : i;
            EpiOut E{F.out, F.out, modl + 5120, F.XG, F.tab + TB_NG + (nl * 2) * 1024, F.mod + (size_t)nl * 4 * 6144 + 1024, F.ssp, (i + 1 < DEPTH) ? 1 : 0, hl};
            pg8::gemm_phase<EpiOut, pg8::StaticOrder, true, true>(F.lds, gm, S, E); } PH_END
    }
    PH_BEGIN if (PHM & 4096) final_phase(F); PH_END
#undef modl
#undef xin_mix
#undef PH_BEGIN
#undef PH_END
}

static int mk_setup(int& grid) {
    int dev = 0, cus = 0, per_cu = 0;
    if (hipGetDevice(&dev) != hipSuccess || hipDeviceGetAttribute(&cus, hipDeviceAttributeMultiprocessorCount, dev) != hipSuccess) return -1;
    if (hipFuncSetAttribute((const void*)mk_fwd, hipFuncAttributeMaxDynamicSharedMemorySize, LDS_BYTES) != hipSuccess) return -1;
    if (hipOccupancyMaxActiveBlocksPerMultiprocessor(&per_cu, (const void*)mk_fwd, NWAVES * 64, LDS_BYTES) != hipSuccess || per_cu < 1) { (void)hipGetLastError(); return -1; }
    grid = cus * per_cu; if (grid > 256) grid = 256;
    return 0;
}
static void mk_launch(void* const* d_in, float* out, void* d_ws, hipStream_t stream) {
    static int grid = 0;
    if (grid == 0) { if (mk_setup(grid) != 0) { fprintf(stderr, "mk_setup failed\n"); grid = -1; } }
    if (grid < 0) return;
    (void)hipMemsetAsync((char*)d_ws + WS_CTL, 0, CTL_ZERO_BYTES, stream);
    Args a{};
    for (int i = 0; i < 20; ++i) a.in[i] = (const float*)d_in[i];
    a.out = out; a.ws = (unsigned char*)d_ws; a.never = 0; a.pad = 0;
#if MK_N_LAUNCHES == 1
    a.ph_lo = 0; a.ph_hi = NPH;
    void* kargs[] = {&a};
    hipError_t e = hipLaunchCooperativeKernel((const void*)mk_fwd, dim3(grid), dim3(NWAVES * 64), kargs, LDS_BYTES, stream);
    if (e != hipSuccess) fprintf(stderr, "cooperative launch failed: %s (grid %d)\n", hipGetErrorString(e), grid);
#else
    for (int ph = 0; ph < NPH; ++ph) { a.ph_lo = ph; a.ph_hi = ph + 1; hipLaunchKernelGGL(mk_fwd, dim3(grid), dim3(NWAVES * 64), LDS_BYTES, stream, a); }
#endif
}

extern "C" void kernel_launch(void* const* d_in, const int* in_sizes, int n_in, void* d_out, int out_size, void* d_ws, size_t ws_size, hipStream_t stream) {
    if (n_in != 20 || ws_size < WS_END) { fprintf(stderr, "kernel_launch: unexpected n_in %d / ws_size %zu (need %zu)\n", n_in, ws_size, (size_t)WS_END); return; }
    mk_launch(d_in, (float*)d_out, d_ws, stream);
}
```

```cpp
#include <hip/hip_runtime.h>
#include <hip/hip_cooperative_groups.h>
#include <cstdio>
#define MK_N_LAUNCHES 1
#define MK_SP2_UP true
namespace pg8 {
#define PG8_LAS __attribute__((address_space(3)))
typedef unsigned short bf16_t;
typedef short bf16x8 __attribute__((ext_vector_type(8)));
typedef float f32x4 __attribute__((ext_vector_type(4)));
typedef unsigned u32x4 __attribute__((ext_vector_type(4)));
constexpr int BM = 256, BK = 64, HALF = 128, HTB = HALF * BK * 2  , STAGE_BYTES = 8 * HTB, NXCD = 8, WGM = 8;

__host__ __device__ __forceinline__ int lds_byte(int r, int c) { const int st = (r >> 4) * 2 + (c >> 5), rr = r & 15, cc = c & 31, ob = rr * 64 + cc * 2; return st * 1024 + (ob ^ (((ob >> 9) & 1) << 5)); }
__host__ __device__ __forceinline__ void stage_rc(int b, int& R, int& C) { const int st = b / 1024, sb = b % 1024, swz = sb ^ (((sb >> 9) & 1) << 5); R = (st >> 1) * 16 + swz / 64; C = (st & 1) * 32 + (swz % 64) / 2; }
__host__ __device__ __forceinline__ int perm32(int rho) { const int n = rho >> 4, i = rho & 15; return 8 * (i >> 2) + 4 * n + (i & 3); }

struct Unit { int pm, pn; };
struct Gemm { const bf16_t* A; const bf16_t* Bt; int M, N, K; };

struct StaticOrder {
    int nM, nN, nwg, G, c;
    __host__ __device__ __forceinline__ void init(int M, int N, int G_, int c_) { nM = M / BM; nN = N / BM; nwg = nM * nN; G = G_; c = c_; }
    __host__ __device__ __forceinline__ bool next(int i, Unit& u) const {
        const long L = (long)i * G + c; if (L >= nwg) return false;
        int wgid = (int)L; { const int q = nwg / NXCD, r = nwg % NXCD, xcd = wgid % NXCD, off = wgid / NXCD; wgid = (xcd < r ? xcd * (q + 1) : r * (q + 1) + (xcd - r) * q) + off; }
        const int nig = WGM * nN, gid = wgid / nig, fm = gid * WGM, gsz = (nM - fm) < WGM ? (nM - fm) : WGM;
        u.pm = fm + ((wgid % nig) % gsz); u.pn = (wgid % nig) / gsz; return true;
    }
    __device__ __forceinline__ void a_ready(const Unit&) const {}
    __device__ __forceinline__ void done(const Unit&) const {}
};

__device__ __forceinline__ unsigned cvt_pk_bf16(float lo, float hi) { unsigned r; asm volatile("v_cvt_pk_bf16_f32 %0, %1, %2" : "=v"(r) : "v"(lo), "v"(hi)); return r; }
typedef float f32x2 __attribute__((ext_vector_type(2)));
__device__ __forceinline__ f32x2 gelu_pk(f32x2 v) {
    const f32x2 av = __builtin_elementwise_abs(v), d = av * 0.2316418882f + 1.0f;
    f32x2 t; t.x = __builtin_amdgcn_rcpf(d.x); t.y = __builtin_amdgcn_rcpf(d.y);
    f32x2 q = t * 0.5307027145f + (-0.7265760135f); q = q * t + 0.7107068705f; q = q * t + (-0.142248368f); q = q * t + 0.127414796f; q = q * t;
    const f32x2 s = (v * v) * (-0.72134752044f);
    f32x2 e; e.x = __builtin_amdgcn_exp2f(s.x); e.y = __builtin_amdgcn_exp2f(s.y);
    const f32x2 m = v * (q * e), r = v - m;
    f32x2 o; o.x = v.x < 0.f ? m.x : r.x; o.y = v.y < 0.f ? m.y : r.y; return o;
}
template <class Epi, class Sched, bool ALIGN_EPI = false, bool SP2 = false>
__device__ __forceinline__ void gemm_phase(PG8_LAS unsigned char* lds, const Gemm g, const Sched& S, const Epi& E) {
    int tid_ = threadIdx.x; asm volatile("" : "+v"(tid_));
    const int tid = tid_, wid = __builtin_amdgcn_readfirstlane(tid >> 6), lane = tid & 63, wr = wid >> 2, wc = wid & 3, fr = lane & 15, fq = lane >> 4;
    const int K = g.K, nt = K / BK;
    unsigned voffA[2], voffB[2];
#pragma unroll
    for (int i = 0; i < 2; ++i) { int R, C; stage_rc(tid * 16 + i * 8192, R, C); const int Rb = Epi::PERM ? ((R & ~31) + perm32(R & 31)) : R;
        voffA[i] = (unsigned)(R * K + C) * 2u; voffB[i] = (unsigned)(Rb * K + C) * 2u; }
    const size_t kstep = (size_t)(BK * 2);
    const size_t hstep = (size_t)HALF * K * 2;
    const size_t tstep = 2 * hstep;
    const unsigned ldsw = (unsigned)wid * 1024u;
    const int aoff = lds_byte(wr * 64 + fr, fq * 8), boff = lds_byte(wc * 32 + fr, fq * 8);
#define PG8_SA(b, h) (((b) * 2 + (h)) * HTB)
#define PG8_SB(b, h) ((4 + (b) * 2 + (h)) * HTB)
#define PG8_STAGE(bufoff, gbase, voff) do { _Pragma("unroll") for (int _i = 0; _i < 2; ++_i) \
        __builtin_amdgcn_global_load_lds((const unsigned*)((const char*)(gbase) + (voff)[_i]), (PG8_LAS unsigned*)(lds + (bufoff) + ldsw + _i * 8192), 16, 0, 0); } while (0)
#define PG8_LDA(dst, b, h) do { _Pragma("unroll") for (int m = 0; m < 4; ++m) _Pragma("unroll") for (int k = 0; k < 2; ++k) dst[m][k] = *(const PG8_LAS bf16x8*)(lds + PG8_SA(b, h) + aoff + m * 2048 + k * 1024); } while (0)
#define PG8_LDB(dst, b, h) do { _Pragma("unroll") for (int n = 0; n < 2; ++n) _Pragma("unroll") for (int k = 0; k < 2; ++k) dst[n][k] = *(const PG8_LAS bf16x8*)(lds + PG8_SB(b, h) + boff + n * 2048 + k * 1024); } while (0)
#define PG8_MMA(ai, bj, At, Bt) do { __builtin_amdgcn_s_setprio(1); _Pragma("unroll") for (int m = 0; m < 4; ++m) _Pragma("unroll") for (int n = 0; n < 2; ++n) _Pragma("unroll") for (int k = 0; k < 2; ++k) \
        acc[ai][bj][m][n] = __builtin_amdgcn_mfma_f32_16x16x32_bf16(Bt[n][k], At[m][k], acc[ai][bj][m][n], 0, 0, 0); __builtin_amdgcn_s_setprio(0); } while (0)
#define PG8_WAIT_V(n) asm volatile("s_waitcnt vmcnt(" #n ")" ::: "memory")
#define PG8_WAIT_L(n) asm volatile("s_waitcnt lgkmcnt(" #n ")" ::: "memory")
#define PG8_BAR __builtin_amdgcn_s_barrier()
#define PG8_SCHED __builtin_amdgcn_sched_barrier(0)
    Unit cur, nxt; int ui = 0;
    if (!S.next(0, cur)) return;
    f32x4 acc[2][2][4][2];
#pragma unroll
    for (int a = 0; a < 2; ++a)
#pragma unroll
        for (int b = 0; b < 2; ++b)
#pragma unroll
            for (int m = 0; m < 4; ++m)
#pragma unroll
                for (int n = 0; n < 2; ++n) acc[a][b][m][n] = (f32x4){0.f, 0.f, 0.f, 0.f};
    bf16x8 At[4][2], B0[2][2], B1[2][2];
    const char* cA = (const char*)g.A + (size_t)cur.pm * tstep; const char* cB = (const char*)g.Bt + (size_t)cur.pn * tstep;
    S.a_ready(cur);
    if constexpr (SP2) {
        PG8_STAGE(PG8_SB(0, 0), cB, voffB); PG8_STAGE(PG8_SB(0, 1), cB + hstep, voffB); PG8_STAGE(PG8_SA(0, 0), cA, voffA); PG8_STAGE(PG8_SA(0, 1), cA + hstep, voffA);
        if (wr == 1) PG8_BAR;
        PG8_WAIT_V(2); PG8_BAR;
        PG8_STAGE(PG8_SB(1, 0), cB + kstep, voffB); PG8_STAGE(PG8_SA(1, 0), cA + kstep, voffA); PG8_STAGE(PG8_SB(1, 1), cB + hstep + kstep, voffB);
        PG8_WAIT_V(6); PG8_BAR;
    } else {
        PG8_STAGE(PG8_SB(0, 0), cB, voffB); PG8_STAGE(PG8_SA(0, 0), cA, voffA); PG8_STAGE(PG8_SB(0, 1), cB + hstep, voffB); PG8_STAGE(PG8_SA(0, 1), cA + hstep, voffA);
        if (wr == 1) PG8_BAR;
        PG8_WAIT_V(4); PG8_BAR;
        PG8_STAGE(PG8_SB(1, 0), cB + kstep, voffB); PG8_STAGE(PG8_SA(1, 0), cA + kstep, voffA); PG8_STAGE(PG8_SB(1, 1), cB + hstep + kstep, voffB);
        PG8_WAIT_V(6); PG8_BAR;
    }
    for (;;) {
        const bool has_next = S.next(ui + 1, nxt);
        const char* nA = has_next ? (const char*)g.A + (size_t)nxt.pm * tstep : cA; const char* nB = has_next ? (const char*)g.Bt + (size_t)nxt.pn * tstep : cB;
        for (int t = 0; t < nt; t += 2) {
            const bool last = (t == nt - 2);
            const char* a1 = cA + (size_t)(t + 1) * kstep;
            const char* a2 = last ? nA : cA + (size_t)(t + 2) * kstep; const char* b2 = last ? nB : cB + (size_t)(t + 2) * kstep;
            const char* a3 = a2 + kstep; const char* b3 = b2 + kstep;
            if (last && has_next) S.a_ready(nxt);
            if constexpr (SP2) {
            PG8_LDB(B0, 0, 0); PG8_LDB(B1, 0, 1); PG8_SCHED; PG8_LDA(At, 0, 0); PG8_STAGE(PG8_SA(1, 1), a1 + hstep, voffA);
            PG8_WAIT_V(8); PG8_WAIT_L(0); PG8_BAR; PG8_MMA(0, 0, At, B0); PG8_MMA(0, 1, At, B1); PG8_BAR; PG8_SCHED;
            PG8_LDA(At, 0, 1); PG8_STAGE(PG8_SB(0, 0), b2, voffB); PG8_STAGE(PG8_SB(0, 1), b2 + hstep, voffB); PG8_STAGE(PG8_SA(0, 0), a2, voffA);
            PG8_WAIT_V(8); PG8_WAIT_L(0); PG8_BAR; PG8_MMA(1, 0, At, B0); PG8_MMA(1, 1, At, B1); PG8_BAR; PG8_SCHED;
            PG8_LDB(B0, 1, 0); PG8_LDB(B1, 1, 1); PG8_SCHED; PG8_LDA(At, 1, 0); PG8_STAGE(PG8_SA(0, 1), a2 + hstep, voffA);
            PG8_WAIT_V(8); PG8_WAIT_L(0); PG8_BAR; PG8_MMA(0, 0, At, B0); PG8_MMA(0, 1, At, B1); PG8_BAR; PG8_SCHED;
            PG8_LDA(At, 1, 1); PG8_STAGE(PG8_SB(1, 0), b3, voffB); PG8_STAGE(PG8_SB(1, 1), b3 + hstep, voffB); PG8_STAGE(PG8_SA(1, 0), a3, voffA);
            PG8_WAIT_V(8); PG8_WAIT_L(0); PG8_BAR; PG8_MMA(1, 0, At, B0); PG8_MMA(1, 1, At, B1); PG8_BAR; PG8_SCHED;
            } else {
            PG8_LDB(B0, 0, 0); PG8_SCHED; PG8_LDA(At, 0, 0); PG8_STAGE(PG8_SA(1, 1), a1 + hstep, voffA);
            PG8_WAIT_L(8); PG8_BAR; PG8_WAIT_L(0); PG8_MMA(0, 0, At, B0); PG8_BAR; PG8_SCHED;
            PG8_LDB(B1, 0, 1); PG8_STAGE(PG8_SB(0, 0), b2, voffB);
            PG8_BAR; PG8_WAIT_L(0); PG8_MMA(0, 1, At, B1); PG8_BAR;
            PG8_LDA(At, 0, 1); PG8_STAGE(PG8_SA(0, 0), a2, voffA);
            PG8_BAR; PG8_WAIT_L(0); PG8_MMA(1, 0, At, B0); PG8_BAR; PG8_SCHED;
            PG8_STAGE(PG8_SB(0, 1), b2 + hstep, voffB);
            PG8_WAIT_V(6); PG8_BAR; PG8_MMA(1, 1, At, B1); PG8_BAR;
            PG8_LDB(B0, 1, 0); PG8_SCHED; PG8_LDA(At, 1, 0); PG8_STAGE(PG8_SA(0, 1), a2 + hstep, voffA);
            PG8_WAIT_L(8); PG8_BAR; PG8_WAIT_L(0); PG8_MMA(0, 0, At, B0); PG8_BAR; PG8_SCHED;
            PG8_LDB(B1, 1, 1); PG8_STAGE(PG8_SB(1, 0), b3, voffB);
            PG8_BAR; PG8_WAIT_L(0); PG8_MMA(0, 1, At, B1); PG8_BAR;
            PG8_LDA(At, 1, 1); PG8_STAGE(PG8_SA(1, 0), a3, voffA);
            PG8_BAR; PG8_WAIT_L(0); PG8_MMA(1, 0, At, B0); PG8_BAR; PG8_SCHED;
            PG8_STAGE(PG8_SB(1, 1), b3 + hstep, voffB);
            PG8_WAIT_V(6); PG8_BAR; PG8_MMA(1, 1, At, B1); PG8_BAR;
            }
        }
        if constexpr (ALIGN_EPI) { if (wr == 0) PG8_BAR; }
        if constexpr (!Epi::AFTER_DRAIN) { E(acc, cur, wr, wc, fr, fq); S.done(cur); }
        if (!has_next) break;
#pragma unroll
        for (int a = 0; a < 2; ++a)
#pragma unroll
            for (int b = 0; b < 2; ++b)
#pragma unroll
                for (int m = 0; m < 4; ++m)
#pragma unroll
                    for (int n = 0; n < 2; ++n) acc[a][b][m][n] = (f32x4){0.f, 0.f, 0.f, 0.f};
        cur = nxt; cA = nA; cB = nB; ++ui;
        if constexpr (ALIGN_EPI) { if (wr == 1) PG8_BAR; }
    }
    PG8_WAIT_V(0);
    if constexpr (!ALIGN_EPI) { if (wr == 0) PG8_BAR; }
    PG8_BAR;
    if constexpr (Epi::AFTER_DRAIN) { E.fused(acc, cur, wr, wc, fr, fq, lds, wid, lane); S.done(cur); }
#undef PG8_SA
#undef PG8_SB
#undef PG8_STAGE
#undef PG8_LDA
#undef PG8_LDB
#undef PG8_MMA
#undef PG8_WAIT_V
#undef PG8_WAIT_L
#undef PG8_BAR
#undef PG8_SCHED
}
}

#ifndef MK_MB
#define MK_MB 4
#endif
#ifndef MK_N_LAUNCHES
#define MK_N_LAUNCHES 1
#endif
constexpr int MB = MK_MB;
constexpr int TT = 4096, D = 1024, M = MB * TT, DEPTH = 4, FF = 2816, FF2 = 5632, GW = 2048;
constexpr float EPS = 1e-6f;
constexpr int NWAVES = 8;
constexpr int NPH = 2 + 2 * 5 + 2 * 7 + 1;
#ifndef MK_PHM
#define MK_PHM 0xffff
#endif
constexpr int PHM = MK_PHM;

constexpr size_t MiB = 1u << 20;
constexpr size_t WS_CTL = 0, CTL_ZERO_BYTES = 2 * MiB;
constexpr size_t WS_MOD = 2 * MiB;
constexpr size_t WS_LB = WS_MOD + 512 * 1024;
constexpr size_t WS_CWP = WS_LB + 64 * 1024;
constexpr size_t WS_CBP = 3 * MiB;
constexpr size_t WS_BWG = 3 * MiB + 256 * 1024;
constexpr size_t WS_BWH = 3 * MiB + 512 * 1024;
constexpr size_t WS_BWU = 3 * MiB + 768 * 1024;
constexpr size_t WS_TAB = 4 * MiB + 256 * 1024;
constexpr int TB_NG = 0, TB_FG = 8192, TB_GN = 9216, TB_LNG = 11264, TB_LNB = 15360, TB_BS = 19456;
constexpr size_t WS_WSB = 4 * MiB + 512 * 1024;
constexpr size_t WS_SSP = 6 * MiB;
constexpr size_t WS_VSTP = 7 * MiB;
constexpr size_t WS_HALO = 11 * MiB;
constexpr size_t WS_DVEC = 17 * MiB;
constexpr size_t WS_WGIN = 18 * MiB, WS_WGOUT = 34 * MiB, WS_WHIN = 42 * MiB, WS_WHOUT = 58 * MiB, WS_WUP = 62 * MiB, WS_WDOWN = 106 * MiB;
constexpr size_t WS_XG = 128 * MiB;
constexpr size_t WS_R = 160 * MiB;
constexpr size_t R_U = 0, R_V = (size_t)M * GW * 2;
constexpr size_t R_G = 0;
constexpr size_t R_Q = 0, R_I = (size_t)M * D * 2, R_GO = 2 * (size_t)M * D * 2, R_LOGF = 3 * (size_t)M * D * 2, R_STATE = R_LOGF + (size_t)M * D * 4;
constexpr size_t WS_END = WS_R + R_STATE + (size_t)MB * 512 * 16384 * 2;
static_assert(MB != 4 || WS_END == 384 * MiB, "d_ws map");
static_assert(WS_BWU + 4 * 4 * 5632 * 4 <= WS_TAB && WS_TAB + 21504 * 4 <= WS_WSB && WS_WSB + 2 * 8 * 16384 * 2 <= WS_SSP && WS_CWP + 4 * 3 * 5632 * 4 <= WS_CBP && WS_CBP + 4 * 5632 * 4 <= WS_BWG && WS_BWG + 2 * 4 * 4096 * 4 <= WS_BWH && WS_BWH + 2 * 4 * 4096 * 4 <= WS_BWU && WS_MOD + 4 * 4 * 6144 * 4 <= WS_LB && WS_LB + 8192 <= WS_CWP, "small tables overlap");
static_assert(WS_SSP + (size_t)M * 16 <= WS_VSTP && WS_VSTP + (size_t)M * 32 * 8 <= WS_HALO && WS_HALO + (size_t)(M / 256) * 4 * 5632 * 4 <= WS_DVEC && WS_DVEC + (size_t)MB * 512 * 128 * 4 <= WS_WGIN && WS_WDOWN + 4 * 1024 * 2816 * 2 <= WS_XG && WS_XG + (size_t)M * 2048 <= WS_R, "d_ws map overlap");

constexpr int RING_BYTES = 131072;
constexpr int HL_OFF = RING_BYTES;
constexpr int MISC_OFF = HL_OFF + 8192;
constexpr int LDS_BYTES = 147456;

#define GAS __attribute__((address_space(1)))
#define LAS __attribute__((address_space(3)))
typedef unsigned short bf16;
typedef unsigned v4u __attribute__((ext_vector_type(4)));
typedef unsigned v2u __attribute__((ext_vector_type(2)));
typedef float f32x4 __attribute__((ext_vector_type(4)));
typedef float f32x2 __attribute__((ext_vector_type(2)));
typedef short bf16x8 __attribute__((ext_vector_type(8)));
typedef short s16x4 __attribute__((ext_vector_type(4)));
#define LDS_WAIT() asm volatile("s_waitcnt lgkmcnt(0)" ::: "memory")
#define VM_WAIT() asm volatile("s_waitcnt vmcnt(0)" ::: "memory")

__device__ __forceinline__ unsigned pk2(float lo, float hi) { return pg8::cvt_pk_bf16(lo, hi); }
__device__ __forceinline__ float bflo(unsigned w) { return __uint_as_float(w << 16); }
__device__ __forceinline__ float bfhi(unsigned w) { return __uint_as_float(w & 0xffff0000u); }
__device__ __forceinline__ float bf2f(bf16 v) { return __uint_as_float(((unsigned)v) << 16); }
__device__ __forceinline__ bf16 f2bf(float f) { return (bf16)(pk2(f, 0.f) & 0xffffu); }
__device__ __forceinline__ float fsigmoid(float v) { return 1.f / (1.f + __expf(-v)); }
__device__ __forceinline__ float fsilu(float v) { return v / (1.f + __expf(-v)); }
__device__ __forceinline__ f32x4 gelu4(f32x4 v) { const f32x2 a = pg8::gelu_pk((f32x2){v.x, v.y}), b = pg8::gelu_pk((f32x2){v.z, v.w}); return (f32x4){a.x, a.y, b.x, b.y}; }
__device__ __forceinline__ float wave_sum(float v) {
#pragma unroll
    for (int o = 1; o < 64; o <<= 1) v += __shfl_xor(v, o);
    return v;
}
__device__ __forceinline__ s16x4 trrd(const LAS unsigned char* p) { typedef short v4i16_t __attribute__((ext_vector_type(4)));
    return __builtin_bit_cast(s16x4, __builtin_amdgcn_ds_read_tr16_b64_v4i16((LAS v4i16_t*)p)); }
__device__ __forceinline__ bf16x8 cat8(s16x4 lo, s16x4 hi) { return (bf16x8){lo[0], lo[1], lo[2], lo[3], hi[0], hi[1], hi[2], hi[3]}; }
template <int CTRL> __device__ __forceinline__ float ror16(float v) { return __int_as_float(__builtin_amdgcn_update_dpp(0, __float_as_int(v), CTRL, 0xf, 0xf, false)); }
__device__ __forceinline__ int up_row(int n) { return n < FF ? (n >> 7) * 256 + (n & 127) : ((n - FF) >> 7) * 256 + 128 + ((n - FF) & 127); }

#define XB_TMO      128
#define XB_XCNT(j)  (256  + 64 * (j))
#define XB_XSUB(j)  (1280 + 64 * (j))
#define XB_XGEN(j)  (2304 + 64 * (j))
#define XB_TOP      3328
#define XB_TOPGEN   3392
#define XCD_BAR_WORDS 3456
#define XB_SPIN_CAP (1u << 18)

__device__ __forceinline__ unsigned xb_ld(unsigned* p)              { return __hip_atomic_load(p, __ATOMIC_RELAXED, __HIP_MEMORY_SCOPE_AGENT); }
__device__ __forceinline__ unsigned xb_add(unsigned* p, unsigned v) { return __hip_atomic_fetch_add(p, v, __ATOMIC_RELAXED, __HIP_MEMORY_SCOPE_AGENT); }
__device__ __forceinline__ unsigned xb_xcc_id() { return (unsigned)__builtin_amdgcn_s_getreg((3 << 11) | 20) & 0xFu; }
#define XB_SPIN(cond, bar) do { unsigned _sp = 0; while (cond) { __builtin_amdgcn_s_sleep(1); \
    if ((++_sp & 255u) == 0u) { if (xb_ld(&(bar)[XB_TMO])) break; if (_sp > XB_SPIN_CAP) { atomicAdd(&(bar)[XB_TMO], 1u); break; } } } } while (0)

struct XcdBarrier {
    unsigned* bar; unsigned x;
    volatile LAS unsigned* st;
};

__device__ __forceinline__ XcdBarrier xcd_barrier_post(unsigned* bar, volatile LAS unsigned* st) {
    XcdBarrier b; b.bar = bar; b.x = xb_xcc_id(); b.st = st;
    if (threadIdx.x == 0) (void)xb_add(&bar[XB_XCNT(b.x)], 1u);
    return b;
}
__device__ __forceinline__ void xcd_barrier_complete(unsigned* bar, unsigned x, unsigned& nloc, unsigned& nx) {
    const unsigned G = gridDim.x * gridDim.y * gridDim.z;
    unsigned sum, cnt, mine, sp = 0u;
    for (;;) {
        sum = 0u; cnt = 0u; mine = 0u;
#pragma unroll
        for (unsigned j = 0; j < 16; ++j) { const unsigned c = xb_ld(&bar[XB_XCNT(j)]); sum += c; cnt += (c > 0u) ? 1u : 0u; mine = (j == x) ? c : mine; }
        if (sum == G) break;
        __builtin_amdgcn_s_sleep(1);
        if ((++sp & 255u) == 0u) { if (xb_ld(&bar[XB_TMO])) break; if (sp > XB_SPIN_CAP) { atomicAdd(&bar[XB_TMO], 1u); break; } }
    }
    nloc = mine > 0u ? mine : 1u; nx = cnt > 0u ? cnt : 1u;
}

__device__ __forceinline__ void xcd_barrier(const XcdBarrier& b) {
    asm volatile("s_waitcnt vmcnt(0)" ::: "memory");
    __syncthreads();
    if (threadIdx.x == 0) {
        unsigned* bar = b.bar;
        __builtin_amdgcn_s_waitcnt(0);
        unsigned nloc = b.st[0], nx = b.st[1];
        if (nloc == 0u) { xcd_barrier_complete(bar, b.x, nloc, nx); b.st[0] = nloc; b.st[1] = nx; }
        const unsigned old = xb_add(&bar[XB_XSUB(b.x)], 1u);
        const unsigned gen = old / nloc;
        if (old + 1u == (gen + 1u) * nloc) {
            __builtin_amdgcn_fence(__ATOMIC_RELEASE, "agent");
            asm volatile("s_waitcnt vmcnt(0)" ::: "memory");
            const unsigned og = xb_add(&bar[XB_TOP], 1u);
            const unsigned tg = og / nx;
            if (og + 1u == (tg + 1u) * nx) xb_add(&bar[XB_TOPGEN], 1u);
            else XB_SPIN(xb_ld(&bar[XB_TOPGEN]) == tg, bar);
            __builtin_amdgcn_fence(__ATOMIC_ACQUIRE, "agent");
            xb_add(&bar[XB_XGEN(b.x)], 1u);
            asm volatile("s_waitcnt vmcnt(0)" ::: "memory");
        } else {
            XB_SPIN(xb_ld(&bar[XB_XGEN(b.x)]) == gen, bar);
            __builtin_amdgcn_fence(__ATOMIC_ACQUIRE, "agent");
            asm volatile("s_waitcnt vmcnt(0)" ::: "memory");
        }
    }
    __syncthreads();
}

struct Args { const float* in[20]; float* out; unsigned char* ws; int ph_lo, ph_hi, never, pad; };
struct Frame {
    LAS unsigned char* lds;
    volatile LAS unsigned* MISC;
    int tid, lane, wave, vcu, G;
    const float *x, *c, *gm_w_in, *gm_ln_g, *gm_ln_b, *gm_w_s, *gm_b_s, *gm_w_out, *hg_w_in, *hg_lb, *hg_gn_g, *hg_w_out, *ffn_w_up, *ffn_conv_w, *ffn_conv_b, *ffn_w_down, *norm_g, *ada_w, *ada_b, *final_g;
    float* out;
    unsigned char* ws;
    float *mod, *lb, *cwp, *cbp, *bwg, *bwh, *bwu, *ssp, *halo, *dvec, *tab; f32x2* vstp; bf16* wsb;
    bf16 *Wgin, *Wgout, *Whin, *Whout, *Wup, *Wdown, *XG, *R;
    __device__ __forceinline__ void bind(const Args& args, bool inputs) {
        GAS unsigned char* wg = (GAS unsigned char*)args.ws; GAS float* og = (GAS float*)args.out; const GAS float* xg0 = (const GAS float*)args.in[0];
        asm volatile("" : "+s"(wg), "+s"(og), "+s"(xg0));
        unsigned char* w = (unsigned char*)wg; float* o = (float*)og; const float* x0 = (const float*)xg0;
        ws = w; out = o; x = x0;
        if (inputs) { c = args.in[1]; gm_w_in = args.in[2]; gm_ln_g = args.in[3]; gm_ln_b = args.in[4]; gm_w_s = args.in[5]; gm_b_s = args.in[6]; gm_w_out = args.in[7];
            hg_w_in = args.in[8]; hg_lb = args.in[9]; hg_gn_g = args.in[10]; hg_w_out = args.in[11]; ffn_w_up = args.in[12]; ffn_conv_w = args.in[13]; ffn_conv_b = args.in[14];
            ffn_w_down = args.in[15]; norm_g = args.in[16]; ada_w = args.in[17]; ada_b = args.in[18]; final_g = args.in[19]; }
        mod = (float*)(w + WS_MOD); lb = (float*)(w + WS_LB); cwp = (float*)(w + WS_CWP); cbp = (float*)(w + WS_CBP); bwg = (float*)(w + WS_BWG); bwh = (float*)(w + WS_BWH); bwu = (float*)(w + WS_BWU);
        tab = (float*)(w + WS_TAB); wsb = (bf16*)(w + WS_WSB); ssp = (float*)(w + WS_SSP); vstp = (f32x2*)(w + WS_VSTP); halo = (float*)(w + WS_HALO); dvec = (float*)(w + WS_DVEC);
        Wgin = (bf16*)(w + WS_WGIN); Wgout = (bf16*)(w + WS_WGOUT); Whin = (bf16*)(w + WS_WHIN); Whout = (bf16*)(w + WS_WHOUT); Wup = (bf16*)(w + WS_WUP); Wdown = (bf16*)(w + WS_WDOWN);
        XG = (bf16*)(w + WS_XG); R = (bf16*)(w + WS_R);
    }
};

__device__ __forceinline__ float row_rstd(const float* ssp, int row) {
    const f32x4 s = *(const f32x4*)(ssp + (size_t)row * 4);
    return rsqrtf(((s.x + s.y) + (s.z + s.w)) * (1.f / 1024.f) + EPS);
}

struct EpiGin {
    static constexpr bool PERM = true, AFTER_DRAIN = false;
    const float* ssp; const float* bw; bf16* U; bf16* V; f32x2* vstp;
    __device__ __forceinline__ void operator()(f32x4 (&acc)[2][2][4][2], const pg8::Unit& u, int wr, int wc, int fr_, int fq_) const {
        int fr = fr_, fq = fq_; asm volatile("" : "+v"(fr), "+v"(fq));
        const int b = u.pm >> 4, col0 = u.pn * 256 + wc * 32 + 8 * fq, rowb = u.pm * 256 + wr * 64 + fr;
        const bool isv = u.pn >= 8; bf16* base = isv ? V : U; const int cc0 = (u.pn & 7) * 256 + wc * 32 + 8 * fq;
        f32x4 bv[2][2];
#pragma unroll
        for (int bj = 0; bj < 2; ++bj)
#pragma unroll
            for (int n = 0; n < 2; ++n) bv[bj][n] = *(const f32x4*)(bw + b * 4096 + col0 + bj * 128 + 4 * n);
#pragma unroll
        for (int ai = 0; ai < 2; ++ai)
#pragma unroll
            for (int m = 0; m < 4; ++m) {
                const int row = rowb + ai * 128 + m * 16; const float rs = row_rstd(ssp, row); float s = 0.f, q = 0.f;
#pragma unroll
                for (int bj = 0; bj < 2; ++bj) {
                    const f32x4 v0 = gelu4(acc[ai][bj][m][0] * rs + bv[bj][0]), v1 = gelu4(acc[ai][bj][m][1] * rs + bv[bj][1]);
                    v4u w; w.x = pk2(v0.x, v0.y); w.y = pk2(v0.z, v0.w); w.z = pk2(v1.x, v1.y); w.w = pk2(v1.z, v1.w);
                    *(v4u*)(base + (size_t)row * GW + cc0 + bj * 128) = w;
                    s += ((v0.x + v0.y) + (v0.z + v0.w)) + ((v1.x + v1.y) + (v1.z + v1.w));
                    q += ((v0.x * v0.x + v0.y * v0.y) + (v0.z * v0.z + v0.w * v0.w)) + ((v1.x * v1.x + v1.y * v1.y) + (v1.z * v1.z + v1.w * v1.w));
                }
                if (isv) { s += __shfl_xor(s, 16); s += __shfl_xor(s, 32); q += __shfl_xor(q, 16); q += __shfl_xor(q, 32);
                    if (fq == 0) vstp[(size_t)row * 32 + (u.pn - 8) * 4 + wc] = (f32x2){s, q}; }
            }
    }
};
struct EpiHin {
    static constexpr bool PERM = true, AFTER_DRAIN = false;
    const float* ssp; const float* bw; const float* lb; bf16* Q; bf16* I; bf16* GO; float* LOGF;
    __device__ __forceinline__ void operator()(f32x4 (&acc)[2][2][4][2], const pg8::Unit& u, int wr, int wc, int fr_, int fq_) const {
        int fr = fr_, fq = fq_; asm volatile("" : "+v"(fr), "+v"(fq));
        const int b = u.pm >> 4, col0 = u.pn * 256 + wc * 32 + 8 * fq, rowb = u.pm * 256 + wr * 64 + fr;
        const int type = u.pn >> 2, cc0 = (u.pn & 3) * 256 + wc * 32 + 8 * fq;
        f32x4 bv[2][2], lv[2][2];
#pragma unroll
        for (int bj = 0; bj < 2; ++bj)
#pragma unroll
            for (int n = 0; n < 2; ++n) { bv[bj][n] = *(const f32x4*)(bw + b * 4096 + col0 + bj * 128 + 4 * n); lv[bj][n] = *(const f32x4*)(lb + cc0 + bj * 128 + 4 * n); }
        bf16* ob = Q + (size_t)(type == 2 ? 1 : 0) * (size_t)(R_I / 2) + (size_t)(type == 3 ? 1 : 0) * (size_t)(R_GO / 2);
#pragma unroll
        for (int ai = 0; ai < 2; ++ai)
#pragma unroll
            for (int m = 0; m < 4; ++m) {
                const int row = rowb + ai * 128 + m * 16; const float rs = row_rstd(ssp, row);
#pragma unroll
                for (int bj = 0; bj < 2; ++bj) {
                    f32x4 v[2];
#pragma unroll
                    for (int n = 0; n < 2; ++n) v[n] = acc[ai][bj][m][n] * rs + bv[bj][n];
                    if (type == 1) {
#pragma unroll
                        for (int n = 0; n < 2; ++n) { f32x4 o;
#pragma unroll
                            for (int e = 0; e < 4; ++e) { const float z = v[n][e], l = lv[bj][n][e];
                                const float ls = fminf(z, 0.f) - __logf(1.f + __expf(-fabsf(z)));
                                const float f = l + (1.f - l) * fsigmoid(z);
                                o[e] = (l == 0.f) ? ls : __logf(f); }
                            *(f32x4*)(LOGF + (size_t)row * D + cc0 + bj * 128 + 4 * n) = o; }
                    } else {
                        if (type != 2) {
#pragma unroll
                            for (int n = 0; n < 2; ++n)
#pragma unroll
                                for (int e = 0; e < 4; ++e) v[n][e] = fsilu(v[n][e]); }
                        v4u w; w.x = pk2(v[0].x, v[0].y); w.y = pk2(v[0].z, v[0].w); w.z = pk2(v[1].x, v[1].y); w.w = pk2(v[1].z, v[1].w);
                        *(v4u*)(ob + (size_t)row * D + cc0 + bj * 128) = w;
                    }
                }
            }
    }
};
struct EpiOut {
    static constexpr bool PERM = true, AFTER_DRAIN = false;
    const float* xin; float* xout; const float* gate; bf16* XG; const float* ng; const float* scn; float* ssp; int write_xg; LAS float* hl;
    __device__ __forceinline__ void operator()(f32x4 (&acc)[2][2][4][2], const pg8::Unit& u, int wr, int wc, int fr_, int fq_) const {
        int fr = fr_, fq = fq_; asm volatile("" : "+v"(fr), "+v"(fq));
        const int b = u.pm >> 4, col0 = u.pn * 256 + wc * 32 + 8 * fq, rowb = u.pm * 256 + wr * 64 + fr;
        f32x4 gv[2][2], mv[2][2];
#pragma unroll
        for (int bj = 0; bj < 2; ++bj)
#pragma unroll
            for (int n = 0; n < 2; ++n) { const int c = col0 + bj * 128 + 4 * n; gv[bj][n] = *(const f32x4*)(gate + b * 6144 + c);
                mv[bj][n] = (f32x4){0.f, 0.f, 0.f, 0.f};
                if (write_xg) { const f32x4 g4 = *(const f32x4*)(ng + c), s4 = *(const f32x4*)(scn + b * 6144 + c); mv[bj][n] = g4 * (s4 + 1.f); } }
#pragma unroll
        for (int ai = 0; ai < 2; ++ai)
#pragma unroll
            for (int m = 0; m < 4; ++m) {
                const int row = rowb + ai * 128 + m * 16; float q = 0.f;
#pragma unroll
                for (int bj = 0; bj < 2; ++bj) {
                    f32x4 xn[2];
#pragma unroll
                    for (int n = 0; n < 2; ++n) { const size_t off = (size_t)row * D + col0 + bj * 128 + 4 * n;
                        xn[n] = *(const f32x4*)(xin + off) + gv[bj][n] * acc[ai][bj][m][n]; *(f32x4*)(xout + off) = xn[n];
                        q += (xn[n].x * xn[n].x + xn[n].y * xn[n].y) + (xn[n].z * xn[n].z + xn[n].w * xn[n].w); }
                    if (write_xg) { const f32x4 a = xn[0] * mv[bj][0], c = xn[1] * mv[bj][1];
                        v4u w; w.x = pk2(a.x, a.y); w.y = pk2(a.z, a.w); w.z = pk2(c.x, c.y); w.w = pk2(c.z, c.w);
                        *(v4u*)(XG + (size_t)row * D + col0 + bj * 128) = w; }
                }
                q += __shfl_xor(q, 16); q += __shfl_xor(q, 32);
                if (fq == 0) hl[(ai * 128 + wr * 64 + m * 16 + fr) * 4 + wc] = q;
            }
        LDS_WAIT(); __builtin_amdgcn_s_barrier(); asm volatile("" ::: "memory");
        { const int lane = fq * 16 + fr, rl = (wr * 4 + wc) * 32 + (lane & 31);
          if (lane < 32) { const f32x4 t = *(const LAS f32x4*)(hl + rl * 4); ssp[(size_t)(u.pm * 256 + rl) * 4 + u.pn] = (t.x + t.y) + (t.z + t.w); } }
        LDS_WAIT(); __builtin_amdgcn_s_barrier(); asm volatile("" ::: "memory");
    }
};
struct EpiUp {
    static constexpr bool PERM = true, AFTER_DRAIN = false;
    const float* ssp; const float* bw; const float* cw; const float* cb; bf16* G; float* halo; LAS float* hl;
    __device__ __forceinline__ void operator()(f32x4 (&acc)[2][2][4][2], const pg8::Unit& u, int wr, int wc, int fr_, int fq_) const {
        int fr = fr_, fq = fq_; asm volatile("" : "+v"(fr), "+v"(fq));
        const int lane = fq * 16 + fr;
        const int b = u.pm >> 4, col0 = u.pn * 256 + wc * 32 + 8 * fq, lc0 = wc * 32 + 8 * fq, rowb = u.pm * 256 + wr * 64 + fr;
        {   f32x4 bv[2][2];
#pragma unroll
            for (int bj = 0; bj < 2; ++bj)
#pragma unroll
                for (int n = 0; n < 2; ++n) bv[bj][n] = *(const f32x4*)(bw + b * FF2 + col0 + bj * 128 + 4 * n);
#pragma unroll
            for (int ai = 0; ai < 2; ++ai)
#pragma unroll
                for (int m = 0; m < 4; ++m) { const float rs = row_rstd(ssp, rowb + ai * 128 + m * 16);
#pragma unroll
                    for (int bj = 0; bj < 2; ++bj)
#pragma unroll
                        for (int n = 0; n < 2; ++n) acc[ai][bj][m][n] = acc[ai][bj][m][n] * rs + bv[bj][n];
                    asm volatile("" : "+v"(acc[ai][0][m][0]), "+v"(acc[ai][0][m][1]), "+v"(acc[ai][1][m][0]), "+v"(acc[ai][1][m][1])); }
        }
        if (fr >= 14) {
#pragma unroll
            for (int ai = 0; ai < 2; ++ai)
#pragma unroll
                for (int bj = 0; bj < 2; ++bj)
#pragma unroll
                    for (int n = 0; n < 2; ++n) *(LAS f32x4*)(hl + ((ai * 2 + wr) * 2 + (fr - 14)) * 256 + bj * 128 + lc0 + 4 * n) = acc[ai][bj][3][n];
            if (wr == 1) {
#pragma unroll
                for (int bj = 0; bj < 2; ++bj)
#pragma unroll
                    for (int n = 0; n < 2; ++n) *(f32x4*)(halo + ((size_t)u.pm * 4 + 2 + (fr - 14)) * FF2 + col0 + bj * 128 + 4 * n) = acc[1][bj][3][n]; }
        }
        if (fr < 2 && wr == 0) {
#pragma unroll
            for (int bj = 0; bj < 2; ++bj)
#pragma unroll
                for (int n = 0; n < 2; ++n) *(f32x4*)(halo + ((size_t)u.pm * 4 + fr) * FF2 + col0 + bj * 128 + 4 * n) = acc[0][bj][0][n]; }
        LDS_WAIT(); __builtin_amdgcn_s_barrier(); asm volatile("" ::: "memory");
#pragma unroll
        for (int n = 0; n < 2; ++n) {
#pragma unroll
            for (int bj = 0; bj < 2; ++bj) {
                asm volatile("" ::: "memory");
                const int c = col0 + bj * 128 + 4 * n;
                const f32x4 cbv = *(const f32x4*)(cb + c), w0 = *(const f32x4*)(cw + c), w1 = *(const f32x4*)(cw + FF2 + c), w2 = *(const f32x4*)(cw + 2 * FF2 + c);
#pragma unroll
                for (int ai = 0; ai < 2; ++ai) {
                    f32x4 tp, up;
                    if (ai == 0 && wr == 0) { tp = up = (f32x4){0.f, 0.f, 0.f, 0.f}; }
                    else { const int pg = ai * 2 + wr - 1;
                        tp = *(const LAS f32x4*)(hl + (pg * 2 + 1) * 256 + bj * 128 + lc0 + 4 * n);
                        up = *(const LAS f32x4*)(hl + (pg * 2 + (fr == 0 ? 0 : 1)) * 256 + bj * 128 + lc0 + 4 * n); }
#pragma unroll
                    for (int m = 0; m < 4; ++m) {
                        const f32x4 cur = acc[ai][bj][m][n]; f32x4 t, s;
#pragma unroll
                        for (int e = 0; e < 4; ++e) { t[e] = ror16<0x121>(cur[e]); s[e] = ror16<0x122>(cur[e]); }
                        const f32x4 p1 = fr >= 1 ? t : tp, p2 = fr >= 2 ? s : up;
                        acc[ai][bj][m][n] = cbv + w0 * p2 + w1 * p1 + w2 * cur; tp = t; up = s;
                        asm volatile("" : "+v"(acc[ai][bj][m][n]));
                    }
                }
            }
#pragma unroll
            for (int ai = 0; ai < 2; ++ai)
#pragma unroll
                for (int m = 0; m < 4; ++m) {
                    const f32x4 o = gelu4(acc[ai][0][m][n]) * acc[ai][1][m][n];
                    v2u w; w.x = pk2(o.x, o.y); w.y = pk2(o.z, o.w);
                    *(v2u*)(G + (size_t)(rowb + ai * 128 + m * 16) * FF + u.pn * 128 + lc0 + 4 * n) = w;
                }
        }
    }
};
__device__ __forceinline__ void ffn_fixup(Frame& F, int layer, int pm) {
    if ((pm & 15) == 0) return;
    const float* cw = F.cwp + (size_t)layer * 3 * FF2; const float* cb = F.cbp + (size_t)layer * FF2;
    const float* hp = F.halo + (size_t)(pm - 1) * 4 * FF2; const float* hc = F.halo + (size_t)pm * 4 * FF2; bf16* G = F.R + R_G / 2;
    for (int c = F.tid; c < FF; c += NWAVES * 64) {
        const int pgc = (c >> 7) * 256 + (c & 127); float y0[2], y1[2];
#pragma unroll
        for (int bj = 0; bj < 2; ++bj) { const int p = pgc + bj * 128; const float am2 = hp[2 * FF2 + p], am1 = hp[3 * FF2 + p], a0 = hc[p], a1 = hc[FF2 + p];
            const float w0 = cw[p], w1 = cw[FF2 + p], w2 = cw[2 * FF2 + p], bb = cb[p];
            y0[bj] = bb + w0 * am2 + w1 * am1 + w2 * a0; y1[bj] = bb + w0 * am1 + w1 * a0 + w2 * a1; }
        const f32x2 gg = pg8::gelu_pk((f32x2){y0[0], y1[0]});
        G[(size_t)(pm * 256) * FF + c] = f2bf(gg.x * y0[1]); G[(size_t)(pm * 256 + 1) * FF + c] = f2bf(gg.y * y1[1]);
    }
}

__device__ __forceinline__ void p0_transpose_item(const float* W, int K, int N, bf16* WT, bool perm, LAS float* scr, int item, int lane) {
    const int nblk = N / 32, kb = item / nblk, nb = item % nblk, k0 = 64 * kb, n0 = 32 * nb;
#pragma unroll 8
    for (int i = 0; i < 32; ++i) { const int kk = 2 * i + (lane >> 5); scr[kk * 33 + (lane & 31)] = W[(size_t)(k0 + kk) * N + n0 + (lane & 31)]; }
    LDS_WAIT(); asm volatile("" ::: "memory");
    const int c = lane & 7; const int r0 = perm ? up_row(n0) : n0;
#pragma unroll
    for (int j = 0; j < 4; ++j) { const int n = (lane >> 3) + 8 * j; const LAS float* s = scr + (8 * c) * 33 + n;
        v4u o; o.x = pk2(s[0 * 33], s[1 * 33]); o.y = pk2(s[2 * 33], s[3 * 33]); o.z = pk2(s[4 * 33], s[5 * 33]); o.w = pk2(s[6 * 33], s[7 * 33]);
        *(v4u*)(WT + (size_t)(r0 + n) * K + k0 + 8 * c) = o; }
    LDS_WAIT(); asm volatile("" ::: "memory");
}
__device__ __forceinline__ void p0a_phase(Frame& F) {
    LAS float* ldsf = (LAS float*)F.lds;
    constexpr int N_ADA = 4 * 48;
    constexpr int I_GIN = 16 * 128, I_GOUT = 32 * 32, I_HIN = 16 * 128, I_HOUT = 16 * 32, I_UP = 16 * 176, I_DOWN = 44 * 32;
    constexpr int NT = 2 * I_GIN + 2 * I_GOUT + 2 * I_HIN + 2 * I_HOUT + 4 * I_UP + 4 * I_DOWN;
    static_assert(NT % 8 == 0, "wave items");
    for (int it = F.vcu; it < N_ADA + NT / 8; it += F.G) {
        if (it < N_ADA) {
            const int layer = it / 48, nb = it % 48; LAS float* cond = ldsf; LAS float* red = ldsf + 4096;
            for (int i = F.tid; i < 4096; i += NWAVES * 64) cond[i] = fsilu(F.c[i]);
            __syncthreads();
            const int kg = F.tid >> 5, ln = F.tid & 31;
            const float* W = F.ada_w + (size_t)layer * 1024 * 6144 + nb * 128 + ln * 4;
            f32x4 a0 = {0.f, 0.f, 0.f, 0.f}, a1 = a0, a2 = a0, a3 = a0;
#pragma unroll 8
            for (int k = kg * 64; k < kg * 64 + 64; ++k) { const f32x4 w = *(const f32x4*)(W + (size_t)k * 6144); a0 += w * cond[k]; a1 += w * cond[1024 + k]; a2 += w * cond[2048 + k]; a3 += w * cond[3072 + k]; }
            *(LAS f32x4*)(red + (kg * 4 + 0) * 128 + ln * 4) = a0; *(LAS f32x4*)(red + (kg * 4 + 1) * 128 + ln * 4) = a1;
            *(LAS f32x4*)(red + (kg * 4 + 2) * 128 + ln * 4) = a2; *(LAS f32x4*)(red + (kg * 4 + 3) * 128 + ln * 4) = a3;
            __syncthreads();
            { const int b = F.tid >> 7, n = F.tid & 127; float s = 0.f;
#pragma unroll
              for (int k2 = 0; k2 < 16; ++k2) s += red[(k2 * 4 + b) * 128 + n];
              F.mod[(size_t)(layer * 4 + b) * 6144 + nb * 128 + n] = s + F.ada_b[layer * 6144 + nb * 128 + n]; }
            __syncthreads();
        } else {
            LAS float* scr = (LAS float*)(F.lds + F.wave * 16384);
            int r = (it - N_ADA) * 8 + F.wave;
            if (r < 2 * I_GIN) { const int j = r / I_GIN; p0_transpose_item(F.gm_w_in + (size_t)j * 1024 * 4096, 1024, 4096, F.Wgin + (size_t)j * 4096 * 1024, false, scr, r % I_GIN, F.lane); continue; } r -= 2 * I_GIN;
            if (r < 2 * I_GOUT) { const int j = r / I_GOUT; p0_transpose_item(F.gm_w_out + (size_t)j * 2048 * 1024, 2048, 1024, F.Wgout + (size_t)j * 1024 * 2048, false, scr, r % I_GOUT, F.lane); continue; } r -= 2 * I_GOUT;
            if (r < 2 * I_HIN) { const int j = r / I_HIN; p0_transpose_item(F.hg_w_in + (size_t)j * 1024 * 4096, 1024, 4096, F.Whin + (size_t)j * 4096 * 1024, false, scr, r % I_HIN, F.lane); continue; } r -= 2 * I_HIN;
            if (r < 2 * I_HOUT) { const int j = r / I_HOUT; p0_transpose_item(F.hg_w_out + (size_t)j * 1024 * 1024, 1024, 1024, F.Whout + (size_t)j * 1024 * 1024, false, scr, r % I_HOUT, F.lane); continue; } r -= 2 * I_HOUT;
            if (r < 4 * I_UP) { const int i = r / I_UP; p0_transpose_item(F.ffn_w_up + (size_t)i * 1024 * FF2, 1024, FF2, F.Wup + (size_t)i * FF2 * 1024, true, scr, r % I_UP, F.lane); continue; } r -= 4 * I_UP;
            { const int i = r / I_DOWN; p0_transpose_item(F.ffn_w_down + (size_t)i * FF * 1024, FF, 1024, F.Wdown + (size_t)i * 1024 * FF, false, scr, r % I_DOWN, F.lane); }
        }
    }
    if (F.vcu >= F.G - 9 && F.vcu < F.G - 1) {
        for (int mi = 0; mi < 2; ++mi) { const int mh = (F.vcu - (F.G - 9)) * 2 + mi;
            for (int e = F.tid; e < 16384; e += NWAVES * 64) { const int n = e >> 7, m = e & 127; const float v = F.gm_w_s[(size_t)mh * 16384 + e]; F.wsb[(size_t)mh * 16384 + e] = f2bf((n < 64 && m >= 64) ? 0.f : v); } }
    }
    if (F.vcu == F.G - 1) {
        for (int d = F.tid; d < 1024; d += NWAVES * 64) { const float l0 = F.hg_lb[d], l1 = F.hg_lb[1024 + d], mx = fmaxf(l0, l1), e0 = expf(l0 - mx), e1 = expf(l1 - mx); F.lb[d] = 0.f; F.lb[1024 + d] = e1 / (e0 + e1); }
        for (int i = F.tid; i < 8192; i += NWAVES * 64) F.tab[TB_NG + i] = F.norm_g[i];
        for (int i = F.tid; i < 1024; i += NWAVES * 64) F.tab[TB_FG + i] = F.final_g[i];
        for (int i = F.tid; i < 2048; i += NWAVES * 64) { F.tab[TB_GN + i] = F.hg_gn_g[i]; F.tab[TB_BS + i] = F.gm_b_s[i]; }
        for (int i = F.tid; i < 4096; i += NWAVES * 64) { F.tab[TB_LNG + i] = F.gm_ln_g[i]; F.tab[TB_LNB + i] = F.gm_ln_b[i]; }
        for (int i = F.tid; i < 4 * FF2; i += NWAVES * 64) { const int layer = i / FF2, n = i % FF2, p = up_row(n);
            F.cbp[layer * FF2 + p] = F.ffn_conv_b[i];
#pragma unroll
            for (int j = 0; j < 3; ++j) F.cwp[(size_t)(layer * 3 + j) * FF2 + p] = F.ffn_conv_w[(size_t)(layer * 3 + j) * FF2 + n]; }
    }
}
__device__ __forceinline__ void p0b_phase(Frame& F) {
    const int gw = F.vcu * NWAVES + F.wave, NGW = F.G * NWAVES, lane = F.lane;
    for (int mat = 0; mat < 8; ++mat) {
        const bf16* Wt; int nrows, layer, shoff; float* outp;
        if (mat < 2) { Wt = F.Wgin + (size_t)mat * 4096 * 1024; nrows = 4096; layer = 2 * mat; shoff = 0; outp = F.bwg + (size_t)mat * 4 * 4096; }
        else if (mat < 4) { Wt = F.Whin + (size_t)(mat - 2) * 4096 * 1024; nrows = 4096; layer = 2 * (mat - 2) + 1; shoff = 0; outp = F.bwh + (size_t)(mat - 2) * 4 * 4096; }
        else { Wt = F.Wup + (size_t)(mat - 4) * FF2 * 1024; nrows = FF2; layer = mat - 4; shoff = 3072; outp = F.bwu + (size_t)(mat - 4) * 4 * FF2; }
        f32x4 sh[4][4];
#pragma unroll
        for (int b = 0; b < 4; ++b) { const float* sp = F.mod + (size_t)(layer * 4 + b) * 6144 + shoff + 8 * lane;
            sh[b][0] = *(const f32x4*)sp; sh[b][1] = *(const f32x4*)(sp + 4); sh[b][2] = *(const f32x4*)(sp + 512); sh[b][3] = *(const f32x4*)(sp + 516); }
        for (int n = gw; n < nrows; n += NGW) {
            const v4u w0 = *(const v4u*)(Wt + (size_t)n * 1024 + 8 * lane), w1 = *(const v4u*)(Wt + (size_t)n * 1024 + 512 + 8 * lane);
            const f32x4 f0 = {bflo(w0.x), bfhi(w0.x), bflo(w0.y), bfhi(w0.y)}, f1 = {bflo(w0.z), bfhi(w0.z), bflo(w0.w), bfhi(w0.w)};
            const f32x4 f2 = {bflo(w1.x), bfhi(w1.x), bflo(w1.y), bfhi(w1.y)}, f3 = {bflo(w1.z), bfhi(w1.z), bflo(w1.w), bfhi(w1.w)};
            float r[4];
#pragma unroll
            for (int b = 0; b < 4; ++b) { const f32x4 t = sh[b][0] * f0 + sh[b][1] * f1 + sh[b][2] * f2 + sh[b][3] * f3; r[b] = wave_sum((t.x + t.y) + (t.z + t.w)); }
            if (lane == 0) {
#pragma unroll
                for (int b = 0; b < 4; ++b) outp[(size_t)b * nrows + n] = r[b]; }
        }
    }
    for (int m = gw; m < M; m += NGW) {
        const int b = m >> 12; const float* xr = F.x + (size_t)m * D; const float* sc = F.mod + (size_t)(0 * 4 + b) * 6144 + 1024; float ss = 0.f;
#pragma unroll
        for (int j = 0; j < 4; ++j) { const int c = 4 * lane + 256 * j; const f32x4 v = *(const f32x4*)(xr + c), g4 = *(const f32x4*)(F.tab + TB_NG + c), s4 = *(const f32x4*)(sc + c);
            ss += (v.x * v.x + v.y * v.y) + (v.z * v.z + v.w * v.w); const f32x4 o = v * g4 * (s4 + 1.f);
            v2u w; w.x = pk2(o.x, o.y); w.y = pk2(o.z, o.w); *(v2u*)(F.XG + (size_t)m * D + c) = w; }
        ss = wave_sum(ss);
        if (lane < 4) F.ssp[(size_t)m * 4 + lane] = lane == 0 ? ss : 0.f;
    }
}
__device__ __forceinline__ void sg_phase(Frame& F, int j) {
    LAS unsigned char* L = F.lds;
    constexpr int WL_OFF = 0, WL_S = 272, VL_OFF = 128 * 272, VL_S = 528, ST_OFF = VL_OFF + 128 * 528;
    const bf16* wsb = F.wsb + (size_t)j * 8 * 128 * 128; const float* bs = F.tab + TB_BS + j * 8 * 128; const float* lng = F.tab + TB_LNG + j * GW; const float* lnb = F.tab + TB_LNB + j * GW;
    bf16* U = F.R + R_U / 2; const bf16* V = F.R + R_V / 2;
    const int tid = F.tid, l = F.lane, w = F.wave, g = l >> 4, c15 = l & 15, qq = c15 >> 2, p4 = l & 3;
    LAS f32x2* ST = (LAS f32x2*)(L + ST_OFF);
    for (int it = F.vcu; it < (M / 128) * 8; it += F.G) {
        const int tb = it >> 3, h = it & 7; const size_t tok0 = (size_t)tb * 128;
        if (tid < 128) { const f32x2* p = F.vstp + (tok0 + tid) * 32; float s = 0.f, q = 0.f;
#pragma unroll
            for (int i = 0; i < 32; ++i) { const f32x2 v = p[i]; s += v.x; q += v.y; }
            const float mu = s * (1.f / 2048.f), var = q * (1.f / 2048.f) - mu * mu; ST[tid] = (f32x2){mu, rsqrtf(var + EPS)}; }
        { const int n = tid >> 2, c0 = (tid & 3) * 32; const bf16* wp = wsb + ((size_t)(h * 128 + n) * 128 + c0);
#pragma unroll
          for (int i = 0; i < 4; ++i) *(LAS v4u*)(L + WL_OFF + n * WL_S + (c0 + 8 * i) * 2) = *(const v4u*)(wp + 8 * i); }
        __syncthreads();
        { const int p = tid & 31, r0 = tid >> 5; const int ch = h * 256 + 8 * p;
          const f32x4 g0 = *(const f32x4*)(lng + ch), g1 = *(const f32x4*)(lng + ch + 4), b0 = *(const f32x4*)(lnb + ch), b1 = *(const f32x4*)(lnb + ch + 4);
#pragma unroll
          for (int i = 0; i < 8; ++i) { const int m = r0 + 16 * i; const v4u raw = *(const v4u*)(V + (tok0 + m) * GW + ch); const f32x2 st = ST[m];
              f32x4 a = {bflo(raw.x), bfhi(raw.x), bflo(raw.y), bfhi(raw.y)}, b = {bflo(raw.z), bfhi(raw.z), bflo(raw.w), bfhi(raw.w)};
              a = (a - st.x) * st.y * g0 + b0; b = (b - st.x) * st.y * g1 + b1;
              v4u o; o.x = pk2(a.x, a.y); o.y = pk2(a.z, a.w); o.z = pk2(b.x, b.y); o.w = pk2(b.z, b.w);
              *(LAS v4u*)(L + VL_OFF + m * VL_S + p * 16) = o; } }
        __syncthreads();
        f32x4 acc[2][8];
#pragma unroll
        for (int db = 0; db < 2; ++db)
#pragma unroll
            for (int nb = 0; nb < 8; ++nb) acc[db][nb] = (f32x4){0.f, 0.f, 0.f, 0.f};
#pragma unroll
        for (int ks = 0; ks < 4; ++ks) {
            bf16x8 a[2];
#pragma unroll
            for (int db = 0; db < 2; ++db) { const LAS unsigned char* ap = L + VL_OFF + (32 * ks + 8 * g + qq) * VL_S + (32 * w + 16 * db + 4 * p4) * 2;
                a[db] = cat8(trrd(ap), trrd(ap + 4 * VL_S)); }
#pragma unroll
            for (int nb = 0; nb < 8; ++nb) {
                if (ks >= 2 && nb < 4) continue;
                const bf16x8 bfr = *(const LAS bf16x8*)(L + WL_OFF + (16 * nb + c15) * WL_S + (32 * ks + 8 * g) * 2);
#pragma unroll
                for (int db = 0; db < 2; ++db) acc[db][nb] = __builtin_amdgcn_mfma_f32_16x16x32_bf16(a[db], bfr, acc[db][nb], 0, 0, 0);
            }
        }
#pragma unroll
        for (int nb = 0; nb < 8; ++nb) { const int n = 16 * nb + c15; const float bsv = bs[h * 128 + n];
#pragma unroll
            for (int db = 0; db < 2; ++db) { bf16* up = U + (tok0 + n) * GW + h * 256 + 32 * w + 16 * db + 4 * g; const v2u uu = *(const v2u*)up;
                const f32x4 s = acc[db][nb] + bsv; v2u o; o.x = pk2(bflo(uu.x) * s.x, bfhi(uu.x) * s.y); o.y = pk2(bflo(uu.y) * s.z, bfhi(uu.y) * s.w); *(v2u*)up = o; } }
        __syncthreads();
    }
}
__device__ __forceinline__ void s1_phase(Frame& F) {
    LAS unsigned char* VR = F.lds; constexpr int VS = 272;
    const bf16* I = F.R + R_I / 2; const float* LOGF = (const float*)((const unsigned char*)F.R + R_LOGF); bf16* STATE = F.R + R_STATE / 2;
    const int tid = F.tid, l = F.lane, w = F.wave, g = l >> 4, c15 = l & 15, qq = c15 >> 2, p4 = l & 3;
    for (int un = F.vcu; un < MB * 512; un += F.G) {
        const int bh = un >> 6, c = un & 63, b = bh >> 3, h = bh & 7; const size_t t0 = (size_t)b * TT + c * 64;
        { const int p = tid & 15, j0 = tid >> 4;
#pragma unroll
          for (int i = 0; i < 2; ++i) { const int jt = j0 + 32 * i; *(LAS v4u*)(VR + jt * VS + p * 16) = *(const v4u*)(I + (t0 + jt) * D + h * 128 + 8 * p); } }
        const float* lf = LOGF + (t0 + 16 * g) * D + h * 128 + 16 * w + c15;
        float cum[16], kv[16], run = 0.f;
#pragma unroll
        for (int i = 0; i < 16; ++i) { const float x = lf[(size_t)i * D]; run += x; cum[i] = run; kv[i] = 1.f - __expf(x); }
        const float t0q = __shfl(run, c15), t1q = __shfl(run, c15 + 16), t2q = __shfl(run, c15 + 32), t3q = __shfl(run, c15 + 48);
        const float off = (g > 0 ? t0q : 0.f) + (g > 1 ? t1q : 0.f) + (g > 2 ? t2q : 0.f), last = (t0q + t1q) + (t2q + t3q);
        bf16x8 af[2];
#pragma unroll
        for (int ks = 0; ks < 2; ++ks) { float e[8];
#pragma unroll
            for (int jj = 0; jj < 8; ++jj) e[jj] = kv[8 * ks + jj] * __expf(last - off - cum[8 * ks + jj]);
            const v4u pk = {pk2(e[0], e[1]), pk2(e[2], e[3]), pk2(e[4], e[5]), pk2(e[6], e[7])}; af[ks] = __builtin_bit_cast(bf16x8, pk); }
        if (g == 0) F.dvec[(size_t)un * 128 + 16 * w + c15] = __expf(last);
        __syncthreads();
        f32x4 acc[8];
#pragma unroll
        for (int vb = 0; vb < 8; ++vb) acc[vb] = (f32x4){0.f, 0.f, 0.f, 0.f};
#pragma unroll
        for (int ks = 0; ks < 2; ++ks)
#pragma unroll
            for (int vb = 0; vb < 8; ++vb) { const LAS unsigned char* bp = VR + (16 * g + 8 * ks + qq) * VS + (16 * vb + 4 * p4) * 2;
                acc[vb] = __builtin_amdgcn_mfma_f32_16x16x32_bf16(af[ks], cat8(trrd(bp), trrd(bp + 4 * VS)), acc[vb], 0, 0, 0); }
#pragma unroll
        for (int vb = 0; vb < 8; ++vb) { v2u o; o.x = pk2(acc[vb].x, acc[vb].y); o.y = pk2(acc[vb].z, acc[vb].w);
            *(v2u*)(STATE + (size_t)un * 16384 + ((w * 8 + vb) * 64 + l) * 4) = o; }
        __syncthreads();
    }
}
__device__ __forceinline__ void s2_phase(Frame& F) {
    bf16* STATE = F.R + R_STATE / 2;
    for (int gid = F.vcu * (NWAVES * 64) + F.tid; gid < MB * 8 * 4096; gid += F.G * NWAVES * 64) {
        const int bh = gid >> 12, e4 = gid & 4095, w = e4 >> 9, l = e4 & 63, k0 = 16 * w + 4 * (l >> 4);
        f32x4 s = {0.f, 0.f, 0.f, 0.f};
        for (int c0 = 0; c0 < 64; c0 += 8) {
            v2u u[8]; f32x4 d[8];
#pragma unroll
            for (int i = 0; i < 8; ++i) { const size_t un = (size_t)bh * 64 + c0 + i; u[i] = *(const v2u*)(STATE + un * 16384 + e4 * 4); d[i] = *(const f32x4*)(F.dvec + un * 128 + k0); }
#pragma unroll
            for (int i = 0; i < 8; ++i) { const size_t un = (size_t)bh * 64 + c0 + i; v2u o; o.x = pk2(s.x, s.y); o.y = pk2(s.z, s.w); *(v2u*)(STATE + un * 16384 + e4 * 4) = o;
                const f32x4 uf = {bflo(u[i].x), bfhi(u[i].x), bflo(u[i].y), bfhi(u[i].y)}; s = d[i] * s + uf; }
        }
    }
}
__device__ __forceinline__ void s3_phase(Frame& F, int j) {
    LAS unsigned char* L = F.lds; constexpr int RS = 272, PS = 144;
    constexpr int QP = 0, QE = 17408, KP = 34816, VRO = 78336, PL = 95744, TOT = 104960, SS = 107008;
    bf16* Q = F.R + R_Q / 2; const bf16* I = F.R + R_I / 2; const bf16* GO = F.R + R_GO / 2; const float* LOGF = (const float*)((const unsigned char*)F.R + R_LOGF); const bf16* STATE = F.R + R_STATE / 2;
    const float* gn = F.tab + TB_GN + j * D;
    const int tid = F.tid, l = F.lane, w = F.wave, g = l >> 4, c15 = l & 15, qq = c15 >> 2, p4 = l & 3;
    LAS float* tot = (LAS float*)(L + TOT); LAS float* ssl = (LAS float*)(L + SS);
    for (int un = F.vcu; un < MB * 512; un += F.G) {
        const int bh = un >> 6, c = un & 63, b = bh >> 3, h = bh & 7; const size_t t0 = (size_t)b * TT + c * 64;
        const int qg = tid >> 7, k = tid & 127;
        float cl[16], qv[16], kvv[16];
        { const float* lf = LOGF + (t0 + 16 * qg) * D + h * 128 + k; const bf16* qp = Q + (t0 + 16 * qg) * D + h * 128 + k; float run = 0.f;
#pragma unroll
          for (int i = 0; i < 16; ++i) { const float x = lf[(size_t)i * D]; run += x; cl[i] = run; kvv[i] = 1.f - __expf(x); qv[i] = bf2f(qp[(size_t)i * D]); }
          tot[qg * 128 + k] = run; }
        { const int p = tid & 15, j0 = tid >> 4;
#pragma unroll
          for (int i = 0; i < 2; ++i) { const int jt = j0 + 32 * i; *(LAS v4u*)(L + VRO + jt * RS + p * 16) = *(const v4u*)(I + (t0 + jt) * D + h * 128 + 8 * p); } }
        __syncthreads();
        { const float tq0 = tot[k], tq1 = tot[128 + k], tq2 = tot[256 + k];
          const float off = (qg > 0 ? tq0 : 0.f) + (qg > 1 ? tq1 : 0.f) + (qg > 2 ? tq2 : 0.f);
          const int kperm = 32 * (k >> 5) + 8 * ((k >> 2) & 3) + 4 * ((k >> 4) & 1) + (k & 3);
#pragma unroll
          for (int i = 0; i < 16; ++i) { const int tok = 16 * qg + i;
              *(LAS bf16*)(L + QP + tok * RS + k * 2) = f2bf(qv[i] * __expf(cl[i]));
              *(LAS bf16*)(L + QE + tok * RS + kperm * 2) = f2bf(qv[i] * __expf(off + cl[i]));
#pragma unroll
              for (int a = 0; a < 4; ++a) { if (a < qg) continue;
                  float ex = fminf(-cl[i], 80.f);
                  if (a > qg) { float r = (qg == 0 ? tq0 : (qg == 1 ? tq1 : tq2)); if (a > qg + 1) r += (qg == 0 ? tq1 : tq2); if (a > qg + 2) r += tq2; ex = r - cl[i]; }
                  const int kpb = a == 0 ? 0 : (a == 1 ? 16 : (a == 2 ? 48 : 96));
                  *(LAS bf16*)(L + KP + (kpb + tok) * RS + k * 2) = f2bf(kvv[i] * __expf(ex)); } } }
        __syncthreads();
#pragma unroll
        for (int rep = 0; rep < 2; ++rep) {
            const int idx = w + 8 * rep; if (idx >= 10) break;
            const int a = idx == 0 ? 0 : (idx < 3 ? 1 : (idx < 6 ? 2 : 3)), bb = idx - (a == 0 ? 0 : (a == 1 ? 1 : (a == 2 ? 3 : 6)));
            const int kpb = a == 0 ? 0 : (a == 1 ? 16 : (a == 2 ? 48 : 96));
            f32x4 sc = {0.f, 0.f, 0.f, 0.f};
#pragma unroll
            for (int ks = 0; ks < 4; ++ks) { const bf16x8 A = *(const LAS bf16x8*)(L + QP + (16 * a + c15) * RS + (32 * ks + 8 * g) * 2), B = *(const LAS bf16x8*)(L + KP + (kpb + 16 * bb + c15) * RS + (32 * ks + 8 * g) * 2);
                sc = __builtin_amdgcn_mfma_f32_16x16x32_bf16(A, B, sc, 0, 0, 0); }
#pragma unroll
            for (int r = 0; r < 4; ++r) { const int i = 4 * g + r; const float v = (a == bb && c15 > i) ? 0.f : sc[r]; *(LAS bf16*)(L + PL + (16 * a + i) * PS + (16 * bb + c15) * 2) = f2bf(v); }
        }
        if (w == 2 || w == 3) { const int a = w == 2 ? 0 : 2, bb = a + 1;
#pragma unroll
            for (int r = 0; r < 4; ++r) *(LAS bf16*)(L + PL + (16 * a + 4 * g + r) * PS + (16 * bb + c15) * 2) = (bf16)0; }
        __syncthreads();
        f32x4 o[4];
#pragma unroll
        for (int a = 0; a < 4; ++a) o[a] = (f32x4){0.f, 0.f, 0.f, 0.f};
        { bf16x8 vf[2];
#pragma unroll
          for (int ks = 0; ks < 2; ++ks) { const LAS unsigned char* bp = L + VRO + (32 * ks + 8 * g + qq) * RS + (16 * w + 4 * p4) * 2; vf[ks] = cat8(trrd(bp), trrd(bp + 4 * RS)); }
#pragma unroll
          for (int a = 0; a < 4; ++a)
#pragma unroll
              for (int ks = 0; ks < 2; ++ks) { if (a < 2 && ks == 1) continue;
                  const bf16x8 A = *(const LAS bf16x8*)(L + PL + (16 * a + c15) * PS + (32 * ks + 8 * g) * 2); o[a] = __builtin_amdgcn_mfma_f32_16x16x32_bf16(A, vf[ks], o[a], 0, 0, 0); } }
#pragma unroll
        for (int kk = 0; kk < 4; ++kk) {
            const v2u lo = *(const v2u*)(STATE + (size_t)un * 16384 + (((2 * kk) * 8 + w) * 64 + l) * 4), hi = *(const v2u*)(STATE + (size_t)un * 16384 + (((2 * kk + 1) * 8 + w) * 64 + l) * 4);
            const v4u sv = {lo.x, lo.y, hi.x, hi.y}; const bf16x8 sf = __builtin_bit_cast(bf16x8, sv);
#pragma unroll
            for (int a = 0; a < 4; ++a) { const bf16x8 A = *(const LAS bf16x8*)(L + QE + (16 * a + c15) * RS + (32 * kk + 8 * g) * 2); o[a] = __builtin_amdgcn_mfma_f32_16x16x32_bf16(A, sf, o[a], 0, 0, 0); }
        }
#pragma unroll
        for (int a = 0; a < 4; ++a)
#pragma unroll
            for (int r = 0; r < 4; ++r) { float sq = o[a][r] * o[a][r]; sq += __shfl_xor(sq, 1); sq += __shfl_xor(sq, 2); sq += __shfl_xor(sq, 4); sq += __shfl_xor(sq, 8);
                if (c15 == 0) ssl[(16 * a + 4 * g + r) * 8 + w] = sq; }
        __syncthreads();
        { const int col = h * 128 + 16 * w + c15; const float gnv = gn[col];
#pragma unroll
          for (int a = 0; a < 4; ++a)
#pragma unroll
              for (int r = 0; r < 4; ++r) { const int i = 16 * a + 4 * g + r; const f32x4 s0 = *(const LAS f32x4*)(ssl + i * 8), s1 = *(const LAS f32x4*)(ssl + i * 8 + 4);
                  const float rstd = rsqrtf((((s0.x + s0.y) + (s0.z + s0.w)) + ((s1.x + s1.y) + (s1.z + s1.w))) * (1.f / 128.f) + EPS);
                  const size_t off = (t0 + i) * D + col; Q[off] = f2bf(o[a][r] * rstd * gnv * bf2f(GO[off])); } }
        __syncthreads();
    }
}
__device__ __forceinline__ void final_phase(Frame& F) {
    const int gw = F.vcu * NWAVES + F.wave, NGW = F.G * NWAVES, lane = F.lane;
    for (int m = gw; m < M; m += NGW) { const float rs = row_rstd(F.ssp, m); float* xr = F.out + (size_t)m * D;
#pragma unroll
        for (int j = 0; j < 4; ++j) { const int c = 4 * lane + 256 * j; const f32x4 v = *(const f32x4*)(xr + c), g4 = *(const f32x4*)(F.tab + TB_FG + c); *(f32x4*)(xr + c) = v * rs * g4; } }
}

__global__ void __launch_bounds__(NWAVES * 64, 2) mk_fwd(Args args) {
    extern __shared__ __attribute__((aligned(16))) unsigned char lds[];
    Frame F;
    F.lds = (LAS unsigned char*)lds; F.MISC = (volatile LAS unsigned*)(F.lds + MISC_OFF);
    F.tid = threadIdx.x; F.lane = F.tid & 63; F.wave = __builtin_amdgcn_readfirstlane(F.tid >> 6);
    F.G = gridDim.x; { const int bx = blockIdx.x; F.vcu = (F.G % 8 == 0) ? (bx % 8) * (F.G / 8) + bx / 8 : bx; }
    unsigned char* ws = args.ws;
    for (int u = F.tid; u < (LDS_BYTES - MISC_OFF) / 4; u += NWAVES * 64) ((LAS unsigned*)(F.lds + MISC_OFF))[u] = 0u;
    __syncthreads();
    const int lo = args.ph_lo, hi = args.ph_hi;
    XcdBarrier bar; bar.bar = (unsigned*)(ws + WS_CTL) + 4096; bar.x = 0; bar.st = nullptr;
    if (hi - lo > 1) bar = xcd_barrier_post((unsigned*)(ws + WS_CTL) + 4096, F.MISC + 8);
    if (args.never) cooperative_groups::this_grid().sync();
    int ph = 0;
#define PH_BEGIN if (ph >= lo && ph < hi) { { int t_ = threadIdx.x; asm volatile("" : "+v"(t_)); F.tid = t_; F.lane = t_ & 63; F.bind(args, ph < 2); }
#define PH_END   if (ph + 1 < hi) xcd_barrier(bar); } ++ph;
    LAS float* hl = (LAS float*)(F.lds + HL_OFF);

    PH_BEGIN if (PHM & 1) p0a_phase(F); PH_END
    PH_BEGIN if (PHM & 2) p0b_phase(F); PH_END
    for (int i = 0; i < DEPTH; ++i) {
        const int j = i >> 1;
#define modl (F.mod + (size_t)i * 4 * 6144)
#define xin_mix ((i == 0) ? F.x : F.out)
        if ((i & 1) == 0) {
            PH_BEGIN if (PHM & 4) { pg8::Gemm gm{F.XG, F.Wgin + (size_t)j * 4096 * 1024, M, 4096, 1024}; pg8::StaticOrder S; S.init(M, 4096, F.G, (int)blockIdx.x);
                EpiGin E{F.ssp, F.bwg + (size_t)j * 4 * 4096, F.R + R_U / 2, F.R + R_V / 2, F.vstp};
                pg8::gemm_phase<EpiGin, pg8::StaticOrder, true, true>(F.lds, gm, S, E); } PH_END
            PH_BEGIN if (PHM & 8) sg_phase(F, j); PH_END
            PH_BEGIN if (PHM & 16) { pg8::Gemm gm{F.R + R_U / 2, F.Wgout + (size_t)j * 1024 * 2048, M, 1024, 2048}; pg8::StaticOrder S; S.init(M, 1024, F.G, (int)blockIdx.x);
                EpiOut E{xin_mix, F.out, modl + 2048, F.XG, F.tab + TB_NG + (i * 2 + 1) * 1024, modl + 4096, F.ssp, 1, hl};
                pg8::gemm_phase<EpiOut, pg8::StaticOrder, true, true>(F.lds, gm, S, E); } PH_END
        } else {
            PH_BEGIN if (PHM & 32) { pg8::Gemm gm{F.XG, F.Whin + (size_t)j * 4096 * 1024, M, 4096, 1024}; pg8::StaticOrder S; S.init(M, 4096, F.G, (int)blockIdx.x);
                EpiHin E{F.ssp, F.bwh + (size_t)j * 4 * 4096, F.lb + j * 1024, F.R + R_Q / 2, F.R + R_I / 2, F.R + R_GO / 2, (float*)((unsigned char*)F.R + R_LOGF)};
                pg8::gemm_phase<EpiHin, pg8::StaticOrder, true, true>(F.lds, gm, S, E); } PH_END
            PH_BEGIN if (PHM & 64) s1_phase(F); PH_END
            PH_BEGIN if (PHM & 128) s2_phase(F); PH_END
            PH_BEGIN if (PHM & 256) s3_phase(F, j); PH_END
            PH_BEGIN if (PHM & 512) { pg8::Gemm gm{F.R + R_Q / 2, F.Whout + (size_t)j * 1024 * 1024, M, 1024, 1024}; pg8::StaticOrder S; S.init(M, 1024, F.G, (int)blockIdx.x);
                EpiOut E{xin_mix, F.out, modl + 2048, F.XG, F.tab + TB_NG + (i * 2 + 1) * 1024, modl + 4096, F.ssp, 1, hl};
                pg8::gemm_phase<EpiOut, pg8::StaticOrder, true, true>(F.lds, gm, S, E); } PH_END
        }
        PH_BEGIN if (PHM & 1024) { pg8::Gemm gm{F.XG, F.Wup + (size_t)i * FF2 * 1024, M, FF2, 1024}; pg8::StaticOrder S; S.init(M, FF2, F.G, (int)blockIdx.x);
            EpiUp E{F.ssp, F.bwu + (size_t)i * 4 * FF2, F.cwp + (size_t)i * 3 * FF2, F.cbp + (size_t)i * FF2, F.R + R_G / 2, F.halo, hl};
            pg8::gemm_phase<EpiUp, pg8::StaticOrder, true, MK_SP2_UP>(F.lds, gm, S, E); } PH_END
        PH_BEGIN if (PHM & 2048) { pg8::Gemm gm{F.R + R_G / 2, F.Wdown + (size_t)i * 1024 * FF, M, 1024, FF}; pg8::StaticOrder S; S.init(M, 1024, F.G, (int)blockIdx.x);
            { pg8::Unit uu; for (int k = 0; S.next(k, uu); ++k) if (uu.pn == 0 || true) ffn_fixup(F, i, uu.pm); VM_WAIT(); __syncthreads(); }
            const int nl = (i + 1 < DEPTH) ? i + 1 : i;
            EpiOut E{F.out, F.out, modl + 5120, F.XG, F.tab + TB_NG + (nl * 2) * 1024, F.mod + (size_t)nl * 4 * 6144 + 1024, F.ssp, (i + 1 < DEPTH) ? 1 : 0, hl};
            pg8::gemm_phase<EpiOut, pg8::StaticOrder, true, true>(F.lds, gm, S, E); } PH_END
    }
    PH_BEGIN if (PHM & 4096) final_phase(F); PH_END
#undef modl
#undef xin_mix
#undef PH_BEGIN
#undef PH_END
}

static int mk_setup(int& grid) {
    int dev = 0, cus = 0, per_cu = 0;
    if (hipGetDevice(&dev) != hipSuccess || hipDeviceGetAttribute(&cus, hipDeviceAttributeMultiprocessorCount, dev) != hipSuccess) return -1;
    if (hipFuncSetAttribute((const void*)mk_fwd, hipFuncAttributeMaxDynamicSharedMemorySize, LDS_BYTES) != hipSuccess) return -1;
    if (hipOccupancyMaxActiveBlocksPerMultiprocessor(&per_cu, (const void*)mk_fwd, NWAVES * 64, LDS_BYTES) != hipSuccess || per_cu < 1) { (void)hipGetLastError(); return -1; }
    grid = cus * per_cu; if (grid > 256) grid = 256;
    return 0;
}
static void mk_launch(void* const* d_in, float* out, void* d_ws, hipStream_t stream) {
    static int grid = 0;
    if (grid == 0) { if (mk_setup(grid) != 0) { fprintf(stderr, "mk_setup failed\n"); grid = -1; } }
    if (grid < 0) return;
    (void)hipMemsetAsync((char*)d_ws + WS_CTL, 0, CTL_ZERO_BYTES, stream);
    Args a{};
    for (int i = 0; i < 20; ++i) a.in[i] = (const float*)d_in[i];
    a.out = out; a.ws = (unsigned char*)d_ws; a.never = 0; a.pad = 0;
#if MK_N_LAUNCHES == 1
    a.ph_lo = 0; a.ph_hi = NPH;
    void* kargs[] = {&a};
    hipError_t e = hipLaunchCooperativeKernel((const void*)mk_fwd, dim3(grid), dim3(NWAVES * 64), kargs, LDS_BYTES, stream);
    if (e != hipSuccess) fprintf(stderr, "cooperative launch failed: %s (grid %d)\n", hipGetErrorString(e), grid);
#else
    for (int ph = 0; ph < NPH; ++ph) { a.ph_lo = ph; a.ph_hi = ph + 1; hipLaunchKernelGGL(mk_fwd, dim3(grid), dim3(NWAVES * 64), LDS_BYTES, stream, a); }
#endif
}

extern "C" void kernel_launch(void* const* d_in, const int* in_sizes, int n_in, void* d_out, int out_size, void* d_ws, size_t ws_size, hipStream_t stream) {
    if (n_in != 20 || ws_size < WS_END) { fprintf(stderr, "kernel_launch: unexpected n_in %d / ws_size %zu (need %zu)\n", n_in, ws_size, (size_t)WS_END); return; }
    mk_launch(d_in, (float*)d_out, d_ws, stream);
}
```
